# Optimizing an MI355X kernel written in HIP

```python
import jax, jax.numpy as jnp
from jax import lax
import numpy as np

D_MODEL = 1024
BATCH = 1
SEQ = 16384
DEPTH = 1
DEC_BATCH = 8
DEC_SEQ = 4096
PAST_LEN = 128

N_MEM = 256
BLK = 128
WINDOW = 128
ROPE_THETA = 10000.0
EPS = 1e-6
NEG = -1e30
A_HEADS = 8
A_KV_HEADS = 2
A_HEAD_DIM = 64
A_GROUP = A_HEADS // A_KV_HEADS
A_Q = A_HEADS * A_HEAD_DIM
A_KV = A_KV_HEADS * A_HEAD_DIM
B_HEADS = 8
B_Q_LORA = 384
B_KV_LORA = 256
B_NOPE = 64
B_ROPE = 32
B_V = 64
B_OUT = B_HEADS * B_V
C_HEADS = 4
C_HEAD_DIM = 128
C_Q = C_HEADS * C_HEAD_DIM
N_BRANCH = 3
D_FF = 2816
IN_SIZES = (A_Q, A_KV, A_KV, B_Q_LORA, B_KV_LORA, B_ROPE, C_Q, N_BRANCH * D_MODEL)
IN_COLS = A_Q + 2 * A_KV + B_Q_LORA + B_KV_LORA + B_ROPE + C_Q + N_BRANCH * D_MODEL

kernel_name = "hybrid_bidir_encoder_gated_branches"


def rms_norm(x, g):
    xf = x.astype(jnp.float32)
    y = xf * lax.rsqrt(jnp.mean(xf * xf, axis=-1, keepdims=True) + EPS)
    return (y * g.astype(jnp.float32)).astype(x.dtype)


def rope(x):
    S, d = x.shape[1], x.shape[-1]
    inv = ROPE_THETA ** (-jnp.arange(0, d, 2, dtype=jnp.float32) / d)
    ang = jnp.arange(S, dtype=jnp.float32)[:, None] * inv[None, :]
    shape = (S,) + (1,) * (x.ndim - 3) + (d // 2,)
    cos = jnp.cos(ang).reshape(shape)
    sin = jnp.sin(ang).reshape(shape)
    xf = x.astype(jnp.float32)
    x1, x2 = xf[..., : d // 2], xf[..., d // 2:]
    return jnp.concatenate([x1 * cos - x2 * sin, x2 * cos + x1 * sin], axis=-1).astype(x.dtype)


def swiglu(x, w_in, w_out):
    gu = x @ w_in
    g, u = gu[..., :D_FF], gu[..., D_FF:]
    return (jax.nn.silu(g) * u) @ w_out


def split_cols(z, sizes):
    out, o = [], 0
    for s in sizes:
        out.append(z[..., o:o + s])
        o += s
    return out


def window_gqa(q, k, v, sink):
    B, S = q.shape[0], q.shape[1]
    nb = S // BLK
    qb = q.reshape(B, nb, BLK, A_KV_HEADS, A_GROUP, A_HEAD_DIM)

    def band(t):
        tp = jnp.pad(t, ((0, 0), (BLK, BLK), (0, 0), (0, 0))).reshape(B, nb + 2, BLK, A_KV_HEADS, A_HEAD_DIM)
        return jnp.concatenate([tp[:, :-2], tp[:, 1:-1], tp[:, 2:]], axis=2)

    kb, vb = band(k), band(v)
    s = jnp.einsum('bnqkgd,bnjkd->bnkgqj', qb, kb).astype(jnp.float32) * (A_HEAD_DIM ** -0.5)
    qpos = jnp.arange(nb)[:, None, None] * BLK + jnp.arange(BLK)[None, :, None]
    kpos = jnp.arange(nb)[:, None, None] * BLK + jnp.arange(3 * BLK)[None, None, :] - BLK
    valid = (jnp.abs(kpos - qpos) <= WINDOW) & (kpos >= 0) & (kpos < S)
    s = jnp.where(valid[None, :, None, None], s, NEG)
    sink_b = sink.astype(jnp.float32).reshape(1, 1, A_KV_HEADS, A_GROUP, 1, 1)
    m = jnp.maximum(jnp.max(s, axis=-1, keepdims=True), sink_b)
    e = jnp.exp(s - m)
    p = e / (jnp.sum(e, axis=-1, keepdims=True) + jnp.exp(sink_b - m))
    o = jnp.einsum('bnkgqj,bnjkd->bnqkgd', p.astype(v.dtype), vb)
    return o.reshape(B, S, A_Q)


def mla(c_q, c_kv, k_rope_raw, q_norm, w_uq, kv_norm, w_ukv):
    B, S = c_q.shape[0], c_q.shape[1]
    nb = S // BLK
    q = (rms_norm(c_q, q_norm) @ w_uq).reshape(B, S, B_HEADS, B_NOPE + B_ROPE)
    q_nope, q_rope = q[..., :B_NOPE], rope(q[..., B_NOPE:])
    kv = (rms_norm(c_kv, kv_norm) @ w_ukv).reshape(B, S, B_HEADS, B_NOPE + B_V)
    k_nope, v = kv[..., :B_NOPE], kv[..., B_NOPE:]
    k_rope = rope(k_rope_raw)
    qn = q_nope.reshape(B, nb, BLK, B_HEADS, B_NOPE).swapaxes(0, 1)
    qr = q_rope.reshape(B, nb, BLK, B_HEADS, B_ROPE).swapaxes(0, 1)
    scale = (B_NOPE + B_ROPE) ** -0.5

    def one_block(args):
        qn_b, qr_b = args
        s = (jnp.einsum('bqhd,bkhd->bhqk', qn_b, k_nope).astype(jnp.float32)
             + jnp.einsum('bqhr,bkr->bhqk', qr_b, k_rope).astype(jnp.float32)) * scale
        p = jax.nn.softmax(s, axis=-1).astype(v.dtype)
        return jnp.einsum('bhqk,bkhd->bqhd', p, v)

    o = lax.map(one_block, (qn, qr))
    return o.swapaxes(0, 1).reshape(B, S, B_OUT)


def mem_attn(q, mem, mem_norm, w_mem_kv):
    B, S = q.shape[0], q.shape[1]
    kv = rms_norm(mem, mem_norm) @ w_mem_kv
    k = kv[..., :C_Q].reshape(B, N_MEM, C_HEADS, C_HEAD_DIM)
    v = kv[..., C_Q:].reshape(B, N_MEM, C_HEADS, C_HEAD_DIM)
    qh = q.reshape(B, S, C_HEADS, C_HEAD_DIM)
    s = jnp.einsum('bqhd,bmhd->bhqm', qh, k).astype(jnp.float32) * (C_HEAD_DIM ** -0.5)
    p = jax.nn.softmax(s, axis=-1).astype(v.dtype)
    return jnp.einsum('bhqm,bmhd->bqhd', p, v).reshape(B, S, C_Q)


def encoder_layer(x, mem, ffn1_norm, ffn1_w_in, ffn1_w_out, mix_norm, w_in,
                  mla_q_norm, mla_w_uq, mla_kv_norm, mla_w_ukv, attn_sink,
                  mem_norm, w_mem_kv, w_branch_a, w_branch_b, w_branch_c, w_out,
                  ffn2_norm, ffn2_w_in, ffn2_w_out):
    B, S = x.shape[0], x.shape[1]
    x = x + 0.5 * swiglu(rms_norm(x, ffn1_norm), ffn1_w_in, ffn1_w_out)
    u = rms_norm(x, mix_norm)
    z = u @ w_in
    qa, ka, va, cq, ckv, kr, qc, gl = split_cols(z, IN_SIZES)
    qa = rope(qa.reshape(B, S, A_HEADS, A_HEAD_DIM))
    ka = rope(ka.reshape(B, S, A_KV_HEADS, A_HEAD_DIM))
    va = va.reshape(B, S, A_KV_HEADS, A_HEAD_DIM)
    oa = window_gqa(qa, ka, va, attn_sink) @ w_branch_a
    ob = mla(cq, ckv, kr, mla_q_norm, mla_w_uq, mla_kv_norm, mla_w_ukv) @ w_branch_b
    oc = mem_attn(qc, mem, mem_norm, w_mem_kv) @ w_branch_c
    gates = jax.nn.sigmoid(gl.reshape(B, S, N_BRANCH, D_MODEL))
    merged = gates[:, :, 0] * oa + gates[:, :, 1] * ob + gates[:, :, 2] * oc
    x = x + merged @ w_out
    x = x + 0.5 * swiglu(rms_norm(x, ffn2_norm), ffn2_w_in, ffn2_w_out)
    return x


def trunk(x, mem, layer_params, final_norm):
    for l in range(DEPTH):
        x = encoder_layer(x, mem, *[p[l] for p in layer_params])
    return rms_norm(x, final_norm)


def setup_inputs(seed: int = 0) -> dict:
    key = jax.random.key(seed)
    ks = jax.random.split(key, 24)

    def dense(k, shape, fan_in):
        return jax.random.normal(k, shape, jnp.float32) * (fan_in ** -0.5)

    def gain(k, shape):
        return 1.0 + 0.02 * jax.random.normal(k, shape, jnp.float32)

    L = DEPTH
    return {
        "x_prompt": jax.random.normal(ks[0], (BATCH, SEQ, D_MODEL), jnp.float32),
        "x_sample": jax.random.normal(ks[1], (DEC_BATCH, DEC_SEQ, D_MODEL), jnp.float32),
        "mem_prompt": jax.random.normal(ks[2], (BATCH, N_MEM, D_MODEL), jnp.float32),
        "mem_sample": jax.random.normal(ks[3], (DEC_BATCH, N_MEM, D_MODEL), jnp.float32),
        "ffn1_norm": gain(ks[4], (L, D_MODEL)),
        "ffn1_w_in": dense(ks[5], (L, D_MODEL, 2 * D_FF), D_MODEL),
        "ffn1_w_out": dense(ks[6], (L, D_FF, D_MODEL), D_FF),
        "mix_norm": gain(ks[7], (L, D_MODEL)),
        "w_in": dense(ks[8], (L, D_MODEL, IN_COLS), D_MODEL),
        "mla_q_norm": gain(ks[9], (L, B_Q_LORA)),
        "mla_w_uq": dense(ks[10], (L, B_Q_LORA, B_HEADS * (B_NOPE + B_ROPE)), B_Q_LORA),
        "mla_kv_norm": gain(ks[11], (L, B_KV_LORA)),
        "mla_w_ukv": dense(ks[12], (L, B_KV_LORA, B_HEADS * (B_NOPE + B_V)), B_KV_LORA),
        "attn_sink": 0.5 * jax.random.normal(ks[13], (L, A_HEADS), jnp.float32),
        "mem_norm": gain(ks[14], (L, D_MODEL)),
        "w_mem_kv": dense(ks[15], (L, D_MODEL, 2 * C_Q), D_MODEL),
        "w_branch_a": dense(ks[16], (L, A_Q, D_MODEL), A_Q),
        "w_branch_b": dense(ks[17], (L, B_OUT, D_MODEL), B_OUT),
        "w_branch_c": dense(ks[18], (L, C_Q, D_MODEL), C_Q),
        "w_out": dense(ks[19], (L, D_MODEL, D_MODEL), D_MODEL),
        "ffn2_norm": gain(ks[20], (L, D_MODEL)),
        "ffn2_w_in": dense(ks[21], (L, D_MODEL, 2 * D_FF), D_MODEL),
        "ffn2_w_out": dense(ks[22], (L, D_FF, D_MODEL), D_FF),
        "final_norm": gain(ks[23], (D_MODEL,)),
    }


def reference(x_prompt, x_sample, mem_prompt, mem_sample, ffn1_norm, ffn1_w_in, ffn1_w_out,
              mix_norm, w_in, mla_q_norm, mla_w_uq, mla_kv_norm, mla_w_ukv, attn_sink,
              mem_norm, w_mem_kv, w_branch_a, w_branch_b, w_branch_c, w_out,
              ffn2_norm, ffn2_w_in, ffn2_w_out, final_norm):
    layer_params = (ffn1_norm, ffn1_w_in, ffn1_w_out, mix_norm, w_in,
                    mla_q_norm, mla_w_uq, mla_kv_norm, mla_w_ukv, attn_sink,
                    mem_norm, w_mem_kv, w_branch_a, w_branch_b, w_branch_c, w_out,
                    ffn2_norm, ffn2_w_in, ffn2_w_out)
    y_prompt = trunk(x_prompt, mem_prompt, layer_params, final_norm)
    y_sample = trunk(x_sample, mem_sample, layer_params, final_norm)
    return (y_prompt, y_sample)
```

```cpp
#include <hip/hip_runtime.h>
#include <hip/hip_cooperative_groups.h>
#include <cstdio>
#include <cstdint>
namespace cg = cooperative_groups;

#define DI __device__ __forceinline__
#define LAS __attribute__((address_space(3)))
typedef short s16x4 __attribute__((ext_vector_type(4)));
typedef short v4i16_t __attribute__((ext_vector_type(4)));
typedef float f32x16 __attribute__((ext_vector_type(16)));
typedef float f32x2_t __attribute__((ext_vector_type(2)));
typedef __bf16 bf16x2_t __attribute__((ext_vector_type(2)));
typedef unsigned u32x2 __attribute__((ext_vector_type(2)));

namespace pg8 {
#define PG8_LAS __attribute__((address_space(3)))
typedef unsigned short bf16_t;
typedef short bf16x8 __attribute__((ext_vector_type(8)));
typedef float f32x4 __attribute__((ext_vector_type(4)));
typedef unsigned u32x4 __attribute__((ext_vector_type(4)));
constexpr int BM = 256, BK = 64, HALF = 128, HTB = HALF * BK * 2  , STAGE_BYTES = 8 * HTB, NXCD = 8, WGM = 8;

__host__ __device__ __forceinline__ int lds_byte(int r, int c) { const int st = (r >> 4) * 2 + (c >> 5), rr = r & 15, cc = c & 31, ob = rr * 64 + cc * 2; return st * 1024 + (ob ^ (((ob >> 9) & 1) << 5)); }
__host__ __device__ __forceinline__ void stage_rc(int b, int& R, int& C) { const int st = b / 1024, sb = b % 1024, swz = sb ^ (((sb >> 9) & 1) << 5); R = (st >> 1) * 16 + swz / 64; C = (st & 1) * 32 + (swz % 64) / 2; }
__host__ __device__ __forceinline__ int perm32(int rho) { const int n = rho >> 4, i = rho & 15; return 8 * (i >> 2) + 4 * n + (i & 3); }

struct Unit { int pm, pn; };
struct Gemm { const bf16_t* A; const bf16_t* Bt; int M, N, K; };

struct StaticOrder {
    int nM, nN, nwg, G, c;
    __host__ __device__ void init(int M, int N, int G_, int c_) { nM = M / BM; nN = N / BM; nwg = nM * nN; G = G_; c = c_; }
    __host__ __device__ bool next(int i, Unit& u) const {
        const long L = (long)i * G + c; if (L >= nwg) return false;
        int wgid = (int)L; { const int q = nwg / NXCD, r = nwg % NXCD, xcd = wgid % NXCD, off = wgid / NXCD; wgid = (xcd < r ? xcd * (q + 1) : r * (q + 1) + (xcd - r) * q) + off; }
        const int nig = WGM * nN, gid = wgid / nig, fm = gid * WGM, gsz = (nM - fm) < WGM ? (nM - fm) : WGM;
        u.pm = fm + ((wgid % nig) % gsz); u.pn = (wgid % nig) / gsz; return true;
    }
    __device__ __forceinline__ void a_ready(const Unit&) const {}
    __device__ __forceinline__ void done(const Unit&) const {}
};

__device__ __forceinline__ unsigned cvt_pk_bf16(float lo, float hi) { unsigned r; asm volatile("v_cvt_pk_bf16_f32 %0, %1, %2" : "=v"(r) : "v"(lo), "v"(hi)); return r; }
template <class Epi, class Sched, bool ALIGN_EPI = false, bool SP2 = false>
__device__ __forceinline__ void gemm_phase(PG8_LAS unsigned char* lds, const Gemm g, const Sched& S, const Epi& E) {
    int tid_ = threadIdx.x; asm volatile("" : "+v"(tid_));
    const int tid = tid_, wid = __builtin_amdgcn_readfirstlane(tid >> 6), lane = tid & 63, wr = wid >> 2, wc = wid & 3, fr = lane & 15, fq = lane >> 4;
    const int K = g.K, nt = K / BK;
    unsigned voffA[2], voffB[2];
#pragma unroll
    for (int i = 0; i < 2; ++i) { int R, C; stage_rc(tid * 16 + i * 8192, R, C); const int Rb = Epi::PERM ? ((R & ~31) + perm32(R & 31)) : R;
        voffA[i] = (unsigned)(R * K + C) * 2u; voffB[i] = (unsigned)(Rb * K + C) * 2u; }
    const size_t kstep = (size_t)(BK * 2);
    const size_t hstep = (size_t)HALF * K * 2;
    const size_t tstep = 2 * hstep;
    const unsigned ldsw = (unsigned)wid * 1024u;
    const int aoff = lds_byte(wr * 64 + fr, fq * 8), boff = lds_byte(wc * 32 + fr, fq * 8);
#define PG8_SA(b, h) (((b) * 2 + (h)) * HTB)
#define PG8_SB(b, h) ((4 + (b) * 2 + (h)) * HTB)
#define PG8_STAGE(bufoff, gbase, voff) do { _Pragma("unroll") for (int _i = 0; _i < 2; ++_i) \
        __builtin_amdgcn_global_load_lds((const unsigned*)((const char*)(gbase) + (voff)[_i]), (PG8_LAS unsigned*)(lds + (bufoff) + ldsw + _i * 8192), 16, 0, 0); } while (0)
#define PG8_LDA(dst, b, h) do { _Pragma("unroll") for (int m = 0; m < 4; ++m) _Pragma("unroll") for (int k = 0; k < 2; ++k) dst[m][k] = *(const PG8_LAS bf16x8*)(lds + PG8_SA(b, h) + aoff + m * 2048 + k * 1024); } while (0)
#define PG8_LDB(dst, b, h) do { _Pragma("unroll") for (int n = 0; n < 2; ++n) _Pragma("unroll") for (int k = 0; k < 2; ++k) dst[n][k] = *(const PG8_LAS bf16x8*)(lds + PG8_SB(b, h) + boff + n * 2048 + k * 1024); } while (0)
#define PG8_MMA(ai, bj, At, Bt) do { __builtin_amdgcn_s_setprio(1); _Pragma("unroll") for (int m = 0; m < 4; ++m) _Pragma("unroll") for (int n = 0; n < 2; ++n) _Pragma("unroll") for (int k = 0; k < 2; ++k) \
        acc[ai][bj][m][n] = __builtin_amdgcn_mfma_f32_16x16x32_bf16(Bt[n][k], At[m][k], acc[ai][bj][m][n], 0, 0, 0); __builtin_amdgcn_s_setprio(0); } while (0)
#define PG8_WAIT_V(n) asm volatile("s_waitcnt vmcnt(" #n ")" ::: "memory")
#define PG8_WAIT_L(n) asm volatile("s_waitcnt lgkmcnt(" #n ")" ::: "memory")
#define PG8_BAR __builtin_amdgcn_s_barrier()
#define PG8_SCHED __builtin_amdgcn_sched_barrier(0)
    Unit cur, nxt; int ui = 0;
    if (!S.next(0, cur)) return;
    f32x4 acc[2][2][4][2];
#pragma unroll
    for (int a = 0; a < 2; ++a)
#pragma unroll
        for (int b = 0; b < 2; ++b)
#pragma unroll
            for (int m = 0; m < 4; ++m)
#pragma unroll
                for (int n = 0; n < 2; ++n) acc[a][b][m][n] = (f32x4){0.f, 0.f, 0.f, 0.f};
    bf16x8 At[4][2], B0[2][2], B1[2][2];
    const char* cA = (const char*)g.A + (size_t)cur.pm * tstep; const char* cB = (const char*)g.Bt + (size_t)cur.pn * tstep;
    S.a_ready(cur);
    if constexpr (SP2) {
        PG8_STAGE(PG8_SB(0, 0), cB, voffB); PG8_STAGE(PG8_SB(0, 1), cB + hstep, voffB); PG8_STAGE(PG8_SA(0, 0), cA, voffA); PG8_STAGE(PG8_SA(0, 1), cA + hstep, voffA);
        if (wr == 1) PG8_BAR;
        PG8_WAIT_V(2); PG8_BAR;
        PG8_STAGE(PG8_SB(1, 0), cB + kstep, voffB); PG8_STAGE(PG8_SA(1, 0), cA + kstep, voffA); PG8_STAGE(PG8_SB(1, 1), cB + hstep + kstep, voffB);
        PG8_WAIT_V(6); PG8_BAR;
    } else {
        PG8_STAGE(PG8_SB(0, 0), cB, voffB); PG8_STAGE(PG8_SA(0, 0), cA, voffA); PG8_STAGE(PG8_SB(0, 1), cB + hstep, voffB); PG8_STAGE(PG8_SA(0, 1), cA + hstep, voffA);
        if (wr == 1) PG8_BAR;
        PG8_WAIT_V(4); PG8_BAR;
        PG8_STAGE(PG8_SB(1, 0), cB + kstep, voffB); PG8_STAGE(PG8_SA(1, 0), cA + kstep, voffA); PG8_STAGE(PG8_SB(1, 1), cB + hstep + kstep, voffB);
        PG8_WAIT_V(6); PG8_BAR;
    }
    for (;;) {
        const bool has_next = S.next(ui + 1, nxt);
        const char* nA = has_next ? (const char*)g.A + (size_t)nxt.pm * tstep : cA; const char* nB = has_next ? (const char*)g.Bt + (size_t)nxt.pn * tstep : cB;
        for (int t = 0; t < nt; t += 2) {
            const bool last = (t == nt - 2);
            const char* a1 = cA + (size_t)(t + 1) * kstep;
            const char* a2 = last ? nA : cA + (size_t)(t + 2) * kstep; const char* b2 = last ? nB : cB + (size_t)(t + 2) * kstep;
            const char* a3 = a2 + kstep; const char* b3 = b2 + kstep;
            if (last && has_next) S.a_ready(nxt);
            if constexpr (SP2) {
            PG8_LDB(B0, 0, 0); PG8_LDB(B1, 0, 1); PG8_SCHED; PG8_LDA(At, 0, 0); PG8_STAGE(PG8_SA(1, 1), a1 + hstep, voffA);
            PG8_WAIT_V(8); PG8_WAIT_L(0); PG8_BAR; PG8_MMA(0, 0, At, B0); PG8_MMA(0, 1, At, B1); PG8_BAR; PG8_SCHED;
            PG8_LDA(At, 0, 1); PG8_STAGE(PG8_SB(0, 0), b2, voffB); PG8_STAGE(PG8_SB(0, 1), b2 + hstep, voffB); PG8_STAGE(PG8_SA(0, 0), a2, voffA);
            PG8_WAIT_V(8); PG8_WAIT_L(0); PG8_BAR; PG8_MMA(1, 0, At, B0); PG8_MMA(1, 1, At, B1); PG8_BAR; PG8_SCHED;
            PG8_LDB(B0, 1, 0); PG8_LDB(B1, 1, 1); PG8_SCHED; PG8_LDA(At, 1, 0); PG8_STAGE(PG8_SA(0, 1), a2 + hstep, voffA);
            PG8_WAIT_V(8); PG8_WAIT_L(0); PG8_BAR; PG8_MMA(0, 0, At, B0); PG8_MMA(0, 1, At, B1); PG8_BAR; PG8_SCHED;
            PG8_LDA(At, 1, 1); PG8_STAGE(PG8_SB(1, 0), b3, voffB); PG8_STAGE(PG8_SB(1, 1), b3 + hstep, voffB); PG8_STAGE(PG8_SA(1, 0), a3, voffA);
            PG8_WAIT_V(8); PG8_WAIT_L(0); PG8_BAR; PG8_MMA(1, 0, At, B0); PG8_MMA(1, 1, At, B1); PG8_BAR; PG8_SCHED;
            } else {
            PG8_LDB(B0, 0, 0); PG8_SCHED; PG8_LDA(At, 0, 0); PG8_STAGE(PG8_SA(1, 1), a1 + hstep, voffA);
            PG8_WAIT_L(8); PG8_BAR; PG8_WAIT_L(0); PG8_MMA(0, 0, At, B0); PG8_BAR; PG8_SCHED;
            PG8_LDB(B1, 0, 1); PG8_STAGE(PG8_SB(0, 0), b2, voffB);
            PG8_BAR; PG8_WAIT_L(0); PG8_MMA(0, 1, At, B1); PG8_BAR;
            PG8_LDA(At, 0, 1); PG8_STAGE(PG8_SA(0, 0), a2, voffA);
            PG8_BAR; PG8_WAIT_L(0); PG8_MMA(1, 0, At, B0); PG8_BAR; PG8_SCHED;
            PG8_STAGE(PG8_SB(0, 1), b2 + hstep, voffB);
            PG8_WAIT_V(6); PG8_BAR; PG8_MMA(1, 1, At, B1); PG8_BAR;
            PG8_LDB(B0, 1, 0); PG8_SCHED; PG8_LDA(At, 1, 0); PG8_STAGE(PG8_SA(0, 1), a2 + hstep, voffA);
            PG8_WAIT_L(8); PG8_BAR; PG8_WAIT_L(0); PG8_MMA(0, 0, At, B0); PG8_BAR; PG8_SCHED;
            PG8_LDB(B1, 1, 1); PG8_STAGE(PG8_SB(1, 0), b3, voffB);
            PG8_BAR; PG8_WAIT_L(0); PG8_MMA(0, 1, At, B1); PG8_BAR;
            PG8_LDA(At, 1, 1); PG8_STAGE(PG8_SA(1, 0), a3, voffA);
            PG8_BAR; PG8_WAIT_L(0); PG8_MMA(1, 0, At, B0); PG8_BAR; PG8_SCHED;
            PG8_STAGE(PG8_SB(1, 1), b3 + hstep, voffB);
            PG8_WAIT_V(6); PG8_BAR; PG8_MMA(1, 1, At, B1); PG8_BAR;
            }
        }
        if constexpr (ALIGN_EPI) { if (wr == 0) PG8_BAR; }
        if constexpr (!Epi::AFTER_DRAIN) { E(acc, cur, wr, wc, fr, fq); S.done(cur); }
        if (!has_next) break;
#pragma unroll
        for (int a = 0; a < 2; ++a)
#pragma unroll
            for (int b = 0; b < 2; ++b)
#pragma unroll
                for (int m = 0; m < 4; ++m)
#pragma unroll
                    for (int n = 0; n < 2; ++n) acc[a][b][m][n] = (f32x4){0.f, 0.f, 0.f, 0.f};
        cur = nxt; cA = nA; cB = nB; ++ui;
        if constexpr (ALIGN_EPI) { if (wr == 1) PG8_BAR; }
    }
    PG8_WAIT_V(0);
    if constexpr (!ALIGN_EPI) { if (wr == 0) PG8_BAR; }
    PG8_BAR;
    if constexpr (Epi::AFTER_DRAIN) { E.fused(acc, cur, wr, wc, fr, fq, lds, wid, lane); S.done(cur); }
#undef PG8_SA
#undef PG8_SB
#undef PG8_STAGE
#undef PG8_LDA
#undef PG8_LDB
#undef PG8_MMA
#undef PG8_WAIT_V
#undef PG8_WAIT_L
#undef PG8_BAR
#undef PG8_SCHED
}
}

#define GAS __attribute__((address_space(1)))
using pg8::bf16_t; using pg8::bf16x8; using pg8::f32x4; using pg8::u32x4; using pg8::Unit; using pg8::Gemm; using pg8::StaticOrder;

constexpr int T_ALL = 49152, TC = 16384, NCHUNK = 3, DM = 1024, DFF = 2816, NFF2 = 5632, ZLD = 5120, NMEMROWS = 2304;
constexpr int COL_KA = 512, COL_VA = 640, COL_CQ = 768, COL_CKV = 1152, COL_KR = 1408, COL_QC = 1440, COL_GL = 1952;
constexpr float RMS_EPS = 1e-6f;
constexpr float LOG2E = 1.4426950408889634f;
constexpr int LDS_BYTES = 131072 + 64;
constexpr float QSCALE_A = 0.125f * LOG2E, QSCALE_B = 0.10206207261596575f * LOG2E, QSCALE_C = 0.08838834764831845f * LOG2E;

constexpr size_t MiB = 1u << 20;
constexpr size_t WS_W1IN = 0;
constexpr size_t WS_W1OUT = 11 * MiB;
constexpr size_t WS_W2IN = 17 * MiB;
constexpr size_t WS_W2OUT = 28 * MiB;
constexpr size_t WS_WIN = 34 * MiB;
constexpr size_t WS_WUQ = 44 * MiB;
constexpr size_t WS_WUKV = 45 * MiB;
constexpr size_t WS_WMKV = 46 * MiB;
constexpr size_t WS_WBA = 48 * MiB, WS_WBB = 49 * MiB, WS_WBC = 50 * MiB;
constexpr size_t WS_WOUT = 51 * MiB;
constexpr size_t WS_CS64 = 53 * MiB;
constexpr size_t WS_CS32 = 57 * MiB;
constexpr size_t WS_MEMN = 59 * MiB;
constexpr size_t WS_MEMKV = 64 * MiB;
constexpr size_t WS_HB = 69 * MiB;
constexpr size_t WS_BIG = 165 * MiB;
constexpr size_t WS_ACT = WS_BIG;
constexpr size_t WS_Z = WS_BIG;
constexpr size_t WS_QB = WS_BIG + 160 * MiB;
constexpr size_t WS_KVB = WS_BIG + 184 * MiB;
constexpr size_t WS_CQN = WS_BIG + 216 * MiB;
constexpr size_t WS_CKVN = WS_BIG + 228 * MiB;
constexpr size_t WS_KRR = WS_BIG + 236 * MiB;
constexpr size_t WS_OA = WS_BIG + 237 * MiB, WS_OB = WS_BIG + 253 * MiB, WS_OC = WS_BIG + 269 * MiB;
constexpr size_t WS_MRG = WS_BIG + 285 * MiB;
constexpr size_t WS_BAR = WS_BIG + 317 * MiB;
constexpr size_t WS_SS1 = WS_BAR + 64 * 1024, WS_SS2 = WS_BAR + 320 * 1024, WS_SS3 = WS_BAR + 576 * 1024;
constexpr size_t WS_END = WS_BIG + 318 * MiB;

struct Params { const float* in[24]; float* out; unsigned char* ws; };

DI unsigned pk2(float lo, float hi) { f32x2_t v = {lo, hi}; bf16x2_t b = __builtin_convertvector(v, bf16x2_t); return __builtin_bit_cast(unsigned, b); }
DI float bf_lo(unsigned u) { return __uint_as_float(u << 16); }
DI float bf_hi(unsigned u) { return __uint_as_float(u & 0xffff0000u); }
DI float wave_sum(float v) {
#pragma unroll
    for (int o = 1; o < 64; o <<= 1) v += __shfl_xor(v, o);
    return v;
}
DI int tok_pos(int t) { return t < 16384 ? t : ((t - 16384) & 4095); }
DI float sigmoidf_(float v) { return __builtin_amdgcn_rcpf(1.0f + __expf(-v)); }

enum { MAP_NAT = 0, MAP_SWIGLU = 1, MAP_WIN = 2, MAP_UQ = 3 };
DI int slot_col(int kind, int s) {
    if (kind == MAP_NAT) return s;
    const int pn = s >> 8, bj = (s >> 7) & 1, w = s & 127;
    if (kind == MAP_SWIGLU) return bj * DFF + 128 * pn + w;
    if (kind == MAP_WIN) {
        if (pn < 2) return 256 * pn + 64 * (w >> 5) + 32 * bj + (w & 31);
        if (pn == 2) return (w < 64) ? (COL_KA + 64 * (w >> 5) + 32 * bj + (w & 31)) : (COL_VA + 64 * bj + (w - 64));
        return s < 5024 ? s : -1;
    }
    if (pn < 2) return 96 * (s >> 6) + (s & 63);
    return 96 * (w >> 4) + 64 + 16 * bj + (w & 15);
}

DI void transpose_item(const float* __restrict__ W, int K, int N, bf16_t* __restrict__ WT, int kind, int nsb, int item, LAS float* scr, int tid, const float* __restrict__ gain = nullptr) {
    const int kb = item / nsb, sb = item - kb * nsb, k0 = kb * 128, s0 = sb * 64;
    const int ts = tid & 63, tk = tid >> 6;
    const int col = slot_col(kind, s0 + ts);
    float v[16];
#pragma unroll
    for (int i = 0; i < 16; ++i) { const int k = tk + 8 * i; v[i] = (col >= 0) ? ((const GAS float*)W)[(size_t)(k0 + k) * N + col] : 0.f; }
#pragma unroll
    for (int i = 0; i < 16; ++i) { const int k = tk + 8 * i; float x = v[i]; if (gain) x *= ((const GAS float*)gain)[k0 + k]; scr[ts * 129 + k] = x; }
    __syncthreads();
#pragma unroll
    for (int h = 0; h < 2; ++h) {
        const int ch = tid + 512 * h, slot = ch >> 4, kc = ch & 15; const LAS float* s = scr + slot * 129 + 8 * kc;
        u32x4 o; o.x = pk2(s[0], s[1]); o.y = pk2(s[2], s[3]); o.z = pk2(s[4], s[5]); o.w = pk2(s[6], s[7]);
        *(GAS u32x4*)(WT + (size_t)(s0 + slot) * K + k0 + 8 * kc) = o;
    }
    __syncthreads();
}

DI void rms_row_bf16(const float* xrow, const float* g, bf16_t* orow, int lane) {
    const GAS f32x4* xr = (const GAS f32x4*)xrow + lane; const GAS f32x4* gr = (const GAS f32x4*)g + lane;
    f32x4 v[4]; float s = 0.f;
#pragma unroll
    for (int j = 0; j < 4; ++j) { v[j] = xr[64 * j]; s += (v[j].x * v[j].x + v[j].y * v[j].y) + (v[j].z * v[j].z + v[j].w * v[j].w); }
    const float rstd = 1.0f / sqrtf(wave_sum(s) * (1.0f / 1024.0f) + RMS_EPS);
    GAS u32x2* o8 = (GAS u32x2*)orow + lane;
#pragma unroll
    for (int j = 0; j < 4; ++j) { const f32x4 gg = gr[64 * j]; u32x2 o; o.x = pk2(v[j].x * rstd * gg.x, v[j].y * rstd * gg.y); o.y = pk2(v[j].z * rstd * gg.z, v[j].w * rstd * gg.w); o8[64 * j] = o; }
}
DI void rms_row_f32(const float* xrow, const float* g, float* orow, int lane) {
    const GAS f32x4* xr = (const GAS f32x4*)xrow + lane; const GAS f32x4* gr = (const GAS f32x4*)g + lane;
    f32x4 v[4]; float s = 0.f;
#pragma unroll
    for (int j = 0; j < 4; ++j) { v[j] = xr[64 * j]; s += (v[j].x * v[j].x + v[j].y * v[j].y) + (v[j].z * v[j].z + v[j].w * v[j].w); }
    const float rstd = 1.0f / sqrtf(wave_sum(s) * (1.0f / 1024.0f) + RMS_EPS);
    GAS f32x4* o = (GAS f32x4*)orow + lane;
#pragma unroll
    for (int j = 0; j < 4; ++j) { const f32x4 gg = gr[64 * j]; o[64 * j] = (f32x4){v[j].x * rstd * gg.x, v[j].y * rstd * gg.y, v[j].z * rstd * gg.z, v[j].w * rstd * gg.w}; }
}

DI void scale_row_bf16_f32(const bf16_t* xrow, const float* g, float rstd, float* orow, int lane) {
    const GAS u32x4* xr = (const GAS u32x4*)xrow + lane; const GAS f32x4* gr = (const GAS f32x4*)g + 2 * lane;
    GAS f32x4* o = (GAS f32x4*)orow + 2 * lane;
#pragma unroll
    for (int j = 0; j < 2; ++j) {
        const u32x4 v = xr[64 * j]; const f32x4 g0 = gr[128 * j], g1 = gr[128 * j + 1];
        o[128 * j] = (f32x4){bf_lo(v.x) * rstd * g0.x, bf_hi(v.x) * rstd * g0.y, bf_lo(v.y) * rstd * g0.z, bf_hi(v.y) * rstd * g0.w};
        o[128 * j + 1] = (f32x4){bf_lo(v.z) * rstd * g1.x, bf_hi(v.z) * rstd * g1.y, bf_lo(v.w) * rstd * g1.z, bf_hi(v.w) * rstd * g1.w};
    }
}
DI void sincos_acc(float ang, float& c, float& s) {
    const double x = (double)ang;
    const double kd = rint(x * 0.63661977236758134308);
    double r = fma(-kd, 1.57079632679489655800e+00, x); r = fma(-kd, 6.12323399573676603587e-17, r);
    const double r2 = r * r;
    double sp = 1.0 / 6227020800.0; sp = fma(sp, r2, -1.0 / 39916800.0); sp = fma(sp, r2, 1.0 / 362880.0); sp = fma(sp, r2, -1.0 / 5040.0);
    sp = fma(sp, r2, 1.0 / 120.0); sp = fma(sp, r2, -1.0 / 6.0); sp = fma(sp * r2, r, r);
    double cp = 1.0 / 479001600.0; cp = fma(cp, r2, -1.0 / 3628800.0); cp = fma(cp, r2, 1.0 / 40320.0); cp = fma(cp, r2, -1.0 / 720.0);
    cp = fma(cp, r2, 1.0 / 24.0); cp = fma(cp, r2, -0.5); cp = fma(cp, r2, 1.0);
    const int q = ((int)kd) & 3;
    const double sv = (q == 0) ? sp : (q == 1) ? cp : (q == 2) ? -sp : -cp;
    const double cv = (q == 0) ? cp : (q == 1) ? -sp : (q == 2) ? -cp : sp;
    c = (float)cv; s = (float)sv;
}

DI float rstd_of(const float* ss, int row) { return 1.0f / sqrtf(((const GAS float*)ss)[row] * (1.0f / 1024.0f) + RMS_EPS); }
struct EpiSwiglu {
    static constexpr bool PERM = true, AFTER_DRAIN = false;
    bf16_t* O; const float* ss;
    DI void operator()(const f32x4 (&acc)[2][2][4][2], const Unit& u, int wr, int wc, int fr, int fq) const {
        const int row0 = u.pm * 256 + wr * 64 + fr, col0 = u.pn * 128 + wc * 32 + 8 * fq;
#pragma unroll
        for (int ai = 0; ai < 2; ++ai)
#pragma unroll
            for (int m = 0; m < 4; ++m) {
                float r[8]; const float rs = ss ? rstd_of(ss, row0 + ai * 128 + m * 16) : 1.0f;
                const float c1 = -rs * LOG2E, c2 = rs * rs;
#pragma unroll
                for (int n = 0; n < 2; ++n)
#pragma unroll
                    for (int j = 0; j < 4; j += 2) {
                        const f32x2_t g2 = {acc[ai][0][m][n][j], acc[ai][0][m][n][j + 1]}, u2 = {acc[ai][1][m][n][j], acc[ai][1][m][n][j + 1]};
                        const f32x2_t t = g2 * c1; f32x2_t e; e.x = __builtin_amdgcn_exp2f(t.x); e.y = __builtin_amdgcn_exp2f(t.y);
                        const f32x2_t d = e + 1.0f; f32x2_t q; q.x = __builtin_amdgcn_rcpf(d.x); q.y = __builtin_amdgcn_rcpf(d.y);
                        const f32x2_t o2 = (g2 * u2) * (q * c2);
                        r[4 * n + j] = o2.x; r[4 * n + j + 1] = o2.y;
                    }
                u32x4 w; w.x = pk2(r[0], r[1]); w.y = pk2(r[2], r[3]); w.z = pk2(r[4], r[5]); w.w = pk2(r[6], r[7]);
                *(GAS u32x4*)(O + (size_t)(row0 + ai * 128 + m * 16) * DFF + col0) = w;
            }
    }
};
template <int RIN, int ROUT> struct EpiResid {
    static constexpr bool PERM = true, AFTER_DRAIN = false;
    const void* r0p; const void* r1p; int split; void* O; float scale; float* ss;
    struct Raw { f32x4 f[2][2]; u32x4 h[2]; };
    DI void fetch(Raw& q, const Unit& u, size_t ro) const {
#pragma unroll
        for (int bj = 0; bj < 2; ++bj) {
            if (RIN == 0) { const GAS float* rb = (u.pm * 256 < split) ? (const GAS float*)r0p : ((const GAS float*)r1p - (size_t)split * DM); q.f[bj][0] = *(const GAS f32x4*)(rb + ro + bj * 128); q.f[bj][1] = *(const GAS f32x4*)(rb + ro + bj * 128 + 4); }
            else q.h[bj] = *(const GAS u32x4*)((const GAS bf16_t*)r0p + ro + bj * 128);
        }
    }
    DI void operator()(const f32x4 (&acc)[2][2][4][2], const Unit& u, int wr, int wc, int fr, int fq) const {
        const int row0 = u.pm * 256 + wr * 64 + fr, col0 = u.pn * 256 + wc * 32 + 8 * fq;
        constexpr int NB = (RIN == 1) ? 8 : 4;
#pragma unroll
        for (int h0 = 0; h0 < 8; h0 += NB) {
            Raw q[NB];
#pragma unroll
            for (int s = 0; s < NB; ++s) fetch(q[s], u, (size_t)(row0 + ((h0 + s) >> 2) * 128 + ((h0 + s) & 3) * 16) * DM + col0);
            __builtin_amdgcn_sched_barrier(0);
#pragma unroll
            for (int s = 0; s < NB; ++s) {
                const int ai = (h0 + s) >> 2, m = (h0 + s) & 3;
                const int row = row0 + ai * 128 + m * 16;
                const size_t ro = (size_t)row * DM + col0;
                float sq = 0.f;
#pragma unroll
                for (int bj = 0; bj < 2; ++bj) {
                    f32x4 a, bb;
                    if (RIN == 0) { a = q[s].f[bj][0]; bb = q[s].f[bj][1]; }
                    else { const u32x4 g = q[s].h[bj]; a = (f32x4){bf_lo(g.x), bf_hi(g.x), bf_lo(g.y), bf_hi(g.y)}; bb = (f32x4){bf_lo(g.z), bf_hi(g.z), bf_lo(g.w), bf_hi(g.w)}; }
                    a = a + acc[ai][bj][m][0] * scale; bb = bb + acc[ai][bj][m][1] * scale;
                    if (ROUT == 0) { *(GAS f32x4*)((float*)O + ro + bj * 128) = a; *(GAS f32x4*)((float*)O + ro + bj * 128 + 4) = bb; }
                    else {
                        u32x4 w; w.x = pk2(a[0], a[1]); w.y = pk2(a[2], a[3]); w.z = pk2(bb[0], bb[1]); w.w = pk2(bb[2], bb[3]);
                        *(GAS u32x4*)((bf16_t*)O + ro + bj * 128) = w;
                        const float q0 = bf_lo(w.x), q1 = bf_hi(w.x), q2 = bf_lo(w.y), q3 = bf_hi(w.y), q4 = bf_lo(w.z), q5 = bf_hi(w.z), q6 = bf_lo(w.w), q7 = bf_hi(w.w);
                        sq += (q0 * q0 + q1 * q1) + (q2 * q2 + q3 * q3) + (q4 * q4 + q5 * q5) + (q6 * q6 + q7 * q7);
                    }
                }
                if (ROUT == 1) { sq += __shfl_xor(sq, 16); sq += __shfl_xor(sq, 32); if (fq == 0) atomicAdd(ss + row, sq); }
            }
        }
    }
};
struct EpiStore {
    static constexpr bool PERM = true, AFTER_DRAIN = false;
    bf16_t* O; int ldc;
    DI void operator()(const f32x4 (&acc)[2][2][4][2], const Unit& u, int wr, int wc, int fr, int fq) const {
        const int row0 = u.pm * 256 + wr * 64 + fr, col0 = u.pn * 256 + wc * 32 + 8 * fq;
#pragma unroll
        for (int ai = 0; ai < 2; ++ai)
#pragma unroll
            for (int m = 0; m < 4; ++m)
#pragma unroll
                for (int bj = 0; bj < 2; ++bj) {
                    const f32x4 v0 = acc[ai][bj][m][0], v1 = acc[ai][bj][m][1];
                    u32x4 w; w.x = pk2(v0[0], v0[1]); w.y = pk2(v0[2], v0[3]); w.z = pk2(v1[0], v1[1]); w.w = pk2(v1[2], v1[3]);
                    *(GAS u32x4*)(O + (size_t)(row0 + ai * 128 + m * 16) * ldc + col0 + bj * 128) = w;
                }
    }
};
DI void load_cs(const f32x2_t* cs, f32x4 (&tb)[4]) {
    const GAS f32x4* p = (const GAS f32x4*)cs;
#pragma unroll
    for (int q = 0; q < 4; ++q) tb[q] = p[q];
}
DI void rope_store(const f32x4 (&a0)[2], const f32x4 (&a1)[2], const f32x4 (&tb)[4], bf16_t* d1, bf16_t* d2, float sc) {
    float o1[8], o2[8];
#pragma unroll
    for (int i = 0; i < 8; ++i) {
        const float cc = ((i & 1) ? tb[i >> 1].z : tb[i >> 1].x) * sc, sn = ((i & 1) ? tb[i >> 1].w : tb[i >> 1].y) * sc;
        const float x1 = a0[i >> 2][i & 3], x2 = a1[i >> 2][i & 3];
        o1[i] = x1 * cc - x2 * sn; o2[i] = x2 * cc + x1 * sn;
    }
    u32x4 w; w.x = pk2(o1[0], o1[1]); w.y = pk2(o1[2], o1[3]); w.z = pk2(o1[4], o1[5]); w.w = pk2(o1[6], o1[7]); *(GAS u32x4*)d1 = w;
    w.x = pk2(o2[0], o2[1]); w.y = pk2(o2[2], o2[3]); w.z = pk2(o2[4], o2[5]); w.w = pk2(o2[6], o2[7]); *(GAS u32x4*)d2 = w;
}
struct EpiWin {
    static constexpr bool PERM = true, AFTER_DRAIN = false;
    bf16_t* Z; const f32x2_t* cs64; int tok0; const float* ss;
    DI void operator()(const f32x4 (&acc)[2][2][4][2], const Unit& u, int wr, int wc, int fr, int fq) const {
        const int row0 = u.pm * 256 + wr * 64 + fr;
        float rs[8];
#pragma unroll
        for (int s = 0; s < 8; ++s) rs[s] = rstd_of(ss, row0 + (s >> 2) * 128 + (s & 3) * 16);
        const bool ropew = (u.pn < 2) || (u.pn == 2 && wc < 2);
        if (ropew) {
            const int c1 = (u.pn < 2 ? 256 * u.pn : COL_KA) + 64 * wc + 8 * fq;
            const float qsc = (u.pn < 2) ? QSCALE_A : 1.0f;
#pragma unroll
            for (int ai = 0; ai < 2; ++ai) {
                f32x4 tb[4][4];
#pragma unroll
                for (int m = 0; m < 4; ++m) load_cs(cs64 + (size_t)tok_pos(tok0 + row0 + ai * 128 + m * 16) * 32 + 8 * fq, tb[m]);
                __builtin_amdgcn_sched_barrier(0);
#pragma unroll
                for (int m = 0; m < 4; ++m) {
                    bf16_t* zr = Z + (size_t)(row0 + ai * 128 + m * 16) * ZLD + c1;
                    rope_store(acc[ai][0][m], acc[ai][1][m], tb[m], zr, zr + 32, qsc * rs[ai * 4 + m]);
                }
                __builtin_amdgcn_sched_barrier(0);
            }
        } else {
#pragma unroll
            for (int bj = 0; bj < 2; ++bj) {
                const int col = (u.pn == 2) ? (COL_VA + 64 * bj + 32 * (wc - 2) + 8 * fq) : (256 * u.pn + 128 * bj + 32 * wc + 8 * fq);
                const bool sg = col >= COL_GL; const float qs = (col >= COL_QC && col < COL_GL) ? QSCALE_C : 1.0f;
#pragma unroll
                for (int ai = 0; ai < 2; ++ai)
#pragma unroll
                    for (int m = 0; m < 4; ++m) {
                        const float rq = qs * rs[ai * 4 + m];
                        f32x4 v0 = acc[ai][bj][m][0] * rq, v1 = acc[ai][bj][m][1] * rq;
                        if (sg) {
#pragma unroll
                            for (int j = 0; j < 4; ++j) { v0[j] = sigmoidf_(v0[j]); v1[j] = sigmoidf_(v1[j]); }
                        }
                        u32x4 w; w.x = pk2(v0[0], v0[1]); w.y = pk2(v0[2], v0[3]); w.z = pk2(v1[0], v1[1]); w.w = pk2(v1[2], v1[3]);
                        *(GAS u32x4*)(Z + (size_t)(row0 + ai * 128 + m * 16) * ZLD + col) = w;
                        __builtin_amdgcn_sched_barrier(0);
                    }
            }
        }
    }
};
struct EpiUq {
    static constexpr bool PERM = true, AFTER_DRAIN = false;
    bf16_t* Q; const f32x2_t* cs32; int tok0;
    DI void operator()(const f32x4 (&acc)[2][2][4][2], const Unit& u, int wr, int wc, int fr, int fq) const {
        const int row0 = u.pm * 256 + wr * 64 + fr;
        if (u.pn == 2) {
            const int head = 2 * wc + (fq >> 1), i0 = 8 * (fq & 1);
#pragma unroll
            for (int ai = 0; ai < 2; ++ai) {
                f32x4 tb[4][4];
#pragma unroll
                for (int m = 0; m < 4; ++m) load_cs(cs32 + (size_t)tok_pos(tok0 + row0 + ai * 128 + m * 16) * 16 + i0, tb[m]);
                __builtin_amdgcn_sched_barrier(0);
#pragma unroll
                for (int m = 0; m < 4; ++m) {
                    bf16_t* qr = Q + (size_t)(row0 + ai * 128 + m * 16) * 768 + 96 * head + 64 + i0;
                    rope_store(acc[ai][0][m], acc[ai][1][m], tb[m], qr, qr + 16, QSCALE_B);
                }
                __builtin_amdgcn_sched_barrier(0);
            }
        } else {
#pragma unroll
            for (int bj = 0; bj < 2; ++bj) {
                const int s = 256 * u.pn + 128 * bj + 32 * wc + 8 * fq; const int col = 96 * (s >> 6) + (s & 63);
#pragma unroll
                for (int ai = 0; ai < 2; ++ai)
#pragma unroll
                    for (int m = 0; m < 4; ++m) {
                        const f32x4 v0 = acc[ai][bj][m][0] * QSCALE_B, v1 = acc[ai][bj][m][1] * QSCALE_B;
                        u32x4 w; w.x = pk2(v0[0], v0[1]); w.y = pk2(v0[2], v0[3]); w.z = pk2(v1[0], v1[1]); w.w = pk2(v1[2], v1[3]);
                        *(GAS u32x4*)(Q + (size_t)(row0 + ai * 128 + m * 16) * 768 + col) = w;
                    }
            }
        }
    }
};
struct Sched3 {
    StaticOrder base;
    DI bool next(int i, Unit& u) const { Unit bu; const int j = i / 3, br = i - 3 * j; if (!base.next(j, bu)) return false; u.pm = 64 * br + bu.pm; u.pn = 4 * br + bu.pn; return true; }
    DI void a_ready(const Unit&) const {}
    DI void done(const Unit&) const {}
};
struct EpiGate3 {
    static constexpr bool PERM = true, AFTER_DRAIN = false;
    const bf16_t* Z; bf16_t* Mg;
    DI void operator()(const f32x4 (&acc)[2][2][4][2], const Unit& u, int wr, int wc, int fr, int fq) const {
        const int br = u.pm >> 6, pm = u.pm & 63, pn = u.pn & 3;
        const int row0 = pm * 256 + wr * 64 + fr, col0 = pn * 256 + wc * 32 + 8 * fq;
        const GAS bf16_t* zg = (const GAS bf16_t*)Z + COL_GL + 1024 * br + col0; GAS bf16_t* mg = (GAS bf16_t*)Mg + col0;
#pragma unroll
        for (int ai = 0; ai < 2; ++ai) {
            u32x4 gv[4][2], ov[4][2];
#pragma unroll
            for (int m = 0; m < 4; ++m)
#pragma unroll
                for (int bj = 0; bj < 2; ++bj) {
                    const size_t row = row0 + ai * 128 + m * 16;
                    gv[m][bj] = *(const GAS u32x4*)(zg + row * ZLD + bj * 128);
                    if (br > 0) ov[m][bj] = *(const GAS u32x4*)(mg + row * DM + bj * 128); else ov[m][bj] = (u32x4){0u, 0u, 0u, 0u};
                }
            __builtin_amdgcn_sched_barrier(0);
#pragma unroll
            for (int m = 0; m < 4; ++m)
#pragma unroll
                for (int bj = 0; bj < 2; ++bj) {
                    const size_t row = row0 + ai * 128 + m * 16;
                    const u32x4 g = gv[m][bj], o = ov[m][bj];
                    const f32x4 v0 = acc[ai][bj][m][0], v1 = acc[ai][bj][m][1];
                    float r[8] = {bf_lo(g.x) * v0[0], bf_hi(g.x) * v0[1], bf_lo(g.y) * v0[2], bf_hi(g.y) * v0[3], bf_lo(g.z) * v1[0], bf_hi(g.z) * v1[1], bf_lo(g.w) * v1[2], bf_hi(g.w) * v1[3]};
                    r[0] += bf_lo(o.x); r[1] += bf_hi(o.x); r[2] += bf_lo(o.y); r[3] += bf_hi(o.y); r[4] += bf_lo(o.z); r[5] += bf_hi(o.z); r[6] += bf_lo(o.w); r[7] += bf_hi(o.w);
                    u32x4 w; w.x = pk2(r[0], r[1]); w.y = pk2(r[2], r[3]); w.z = pk2(r[4], r[5]); w.w = pk2(r[6], r[7]);
                    *(GAS u32x4*)(mg + row * DM + bj * 128) = w;
                }
        }
    }
};

DI int crow16(int i, int h) { return (i & 3) + 8 * (i >> 2) + 4 * h; }
DI s16x4 vtr(LAS const unsigned char* p) { return __builtin_bit_cast(s16x4, __builtin_amdgcn_ds_read_tr16_b64_v4i16((LAS v4i16_t*)p)); }
#define MFMA32(a, b, c) __builtin_amdgcn_mfma_f32_32x32x16_bf16((a), (b), (c), 0, 0, 0)

DI float max3f(float a, float b, float c) { float r; asm("v_max3_f32 %0, %1, %2, %3" : "=v"(r) : "v"(a), "v"(b), "v"(c)); return r; }

template <int DQK, int D1, int DV, int MODE, int KT>
DI void attn_unit(LAS unsigned char* lds, const bf16_t* __restrict__ Q, int ldq, const bf16_t* __restrict__ K1, int ldk1, const bf16_t* __restrict__ K2, int ldk2,
                  const bf16_t* __restrict__ V, int ldv, bf16_t* __restrict__ O, int ldo, int q0, int kbeg, int kend, float sink_t) {
    constexpr int D2 = DQK - D1, KP = DQK * 2 + 16, VP = DV * 2 + 64  , KBUF = KT * KP, VBUF = KT * VP, BUF = KBUF + VBUF;
    constexpr int N1 = (KT * D1 / 8) / 512, NV = (KT * DV / 8) / 512, C1 = D1 / 8, CV = DV / 8;
    constexpr float THR = 6.0f;
    int tid_ = threadIdx.x; asm volatile("" : "+v"(tid_));
    const int tid = tid_, lane = tid & 63, w = __builtin_amdgcn_readfirstlane(tid >> 6), r = lane & 31, h = lane >> 5;
    const int qi = q0 + 32 * w + r;
    bf16x8 qf[DQK / 16];
    {
        const bf16_t* qrow = Q + (size_t)qi * ldq + 8 * h;
#pragma unroll
        for (int s = 0; s < DQK / 16; ++s) qf[s] = *(const GAS bf16x8*)(qrow + 16 * s);
    }
    f32x16 o[DV / 32];
#pragma unroll
    for (int d = 0; d < DV / 32; ++d)
#pragma unroll
        for (int i = 0; i < 16; ++i) o[d][i] = 0.f;
    float mrun = (MODE == 1) ? sink_t : 0.0f;
    f32x2_t lacc = {(MODE == 1 && h == 0) ? 1.0f : 0.0f, 0.0f};
    f32x16 negm;
#pragma unroll
    for (int i = 0; i < 16; ++i) negm[i] = -mrun;

    u32x4 rk1a[N1], rk2a, rva[NV], rk1b[N1], rk2b, rvb[NV];
    const int ntiles = (kend - kbeg) >> 6;
    const int i16 = lane & 15, tq = i16 >> 2, tp = i16 & 3, tg = (lane >> 4) & 1;
    const int kfo = r * KP + 16 * h;
    const int vfo = (4 * h + tq) * VP + (16 * tg + 4 * tp) * 2;
    f32x16 s0, s1;
    bf16x8 pf[2][2];
#define ATT_GLOAD(S_, kt_) do { \
        _Pragma("unroll") for (int i = 0; i < N1; ++i) { const int ci = tid + 512 * i, key = ci / C1, part = ci % C1; rk1##S_[i] = *(const GAS u32x4*)(K1 + (size_t)((kt_) + key) * ldk1 + 8 * part); } \
        if (D2 > 0 && tid < KT * 4) { const int key = tid >> 2, part = tid & 3; rk2##S_ = *(const GAS u32x4*)(K2 + (size_t)((kt_) + key) * ldk2 + 8 * part); } \
        _Pragma("unroll") for (int i = 0; i < NV; ++i) { const int ci = tid + 512 * i, key = ci / CV, part = ci % CV; rv##S_[i] = *(const GAS u32x4*)(V + (size_t)((kt_) + key) * ldv + 8 * part); } } while (0)
#define ATT_LSTORE(S_, b_) do { \
        _Pragma("unroll") for (int i = 0; i < N1; ++i) { const int ci = tid + 512 * i, key = ci / C1, part = ci % C1; *(LAS u32x4*)((b_) + key * KP + 16 * part) = rk1##S_[i]; } \
        if (D2 > 0 && tid < KT * 4) { const int key = tid >> 2, part = tid & 3; *(LAS u32x4*)((b_) + key * KP + D1 * 2 + 16 * part) = rk2##S_; } \
        _Pragma("unroll") for (int i = 0; i < NV; ++i) { const int ci = tid + 512 * i, key = ci / CV, part = ci % CV; *(LAS u32x4*)((b_) + KBUF + key * VP + 16 * part) = rv##S_[i]; } } while (0)
#define ATT_QK(b_, vb_) do { \
        if (DQK <= 96) {     \
            bf16x8 kfa[DQK / 16], kfb[DQK / 16]; \
            _Pragma("unroll") for (int s = 0; s < DQK / 16; ++s) { kfa[s] = *(const LAS bf16x8*)((b_) + kfo + 32 * s); kfb[s] = *(const LAS bf16x8*)((b_) + kfo + 32 * KP + 32 * s); } \
            ATT_VLOAD(vb_); \
            _Pragma("unroll") for (int s = 0; s < DQK / 16; ++s) { \
                if (s == 0) { s0 = MFMA32(kfa[0], qf[0], negm); s1 = MFMA32(kfb[0], qf[0], negm); } \
                else { s0 = MFMA32(kfa[s], qf[s], s0); s1 = MFMA32(kfb[s], qf[s], s1); } } \
        } else { \
        _Pragma("unroll") for (int s = 0; s < DQK / 16; ++s) { \
            const bf16x8 a0 = *(const LAS bf16x8*)((b_) + kfo + 32 * s); \
            const bf16x8 a1 = *(const LAS bf16x8*)((b_) + kfo + 32 * KP + 32 * s); \
            if (s == 0) { s0 = MFMA32(a0, qf[0], negm); s1 = MFMA32(a1, qf[0], negm); } \
            else { s0 = MFMA32(a0, qf[s], s0); s1 = MFMA32(a1, qf[s], s1); } } } } while (0)
#define ATT_SM(ti_, kt_) do { \
        if (MODE == 1) { \
            _Pragma("unroll") for (int i = 0; i < 16; ++i) { \
                const int key = (kt_) + crow16(i, h); const int d0 = key - qi, d1 = d0 + 32; \
                if (d0 > 128 || d0 < -128) s0[i] = -1e30f; \
                if (d1 > 128 || d1 < -128) s1[i] = -1e30f; } } \
        float ta, tb;     \
        asm volatile("s_nop 15\n\ts_nop 3\n\tv_max3_f32 %0, %1, %2, %3" : "=v"(ta) : "v"(s0[0]), "v"(s0[1]), "v"(s1[0])); \
        asm volatile("v_max3_f32 %0, %1, %2, %3" : "=v"(tb) : "v"(s0[2]), "v"(s0[3]), "v"(s1[1])); \
        asm volatile("v_max3_f32 %0, %1, %2, %3" : "=v"(ta) : "v"(ta), "v"(s1[2]), "v"(s1[3])); \
        _Pragma("unroll") for (int i = 4; i < 16; i += 4) { \
            asm volatile("v_max3_f32 %0, %1, %2, %3" : "=v"(tb) : "v"(tb), "v"(s0[i]), "v"(s0[i + 1])); \
            asm volatile("v_max3_f32 %0, %1, %2, %3" : "=v"(ta) : "v"(ta), "v"(s0[i + 2]), "v"(s0[i + 3])); \
            asm volatile("v_max3_f32 %0, %1, %2, %3" : "=v"(tb) : "v"(tb), "v"(s1[i]), "v"(s1[i + 1])); \
            asm volatile("v_max3_f32 %0, %1, %2, %3" : "=v"(ta) : "v"(ta), "v"(s1[i + 2]), "v"(s1[i + 3])); } \
        float tmax = max3f(ta, tb, tb); \
        { const auto sw_ = __builtin_amdgcn_permlane32_swap(__float_as_uint(tmax), __float_as_uint(tmax), false, false);     \
          tmax = max3f(__uint_as_float(sw_[0]), __uint_as_float(sw_[1]), tmax); } \
        const bool first0 = (MODE == 0) && ((ti_) == 0); \
        if (first0 || __any(tmax > THR)) { \
            const float delta = first0 ? tmax : fmaxf(tmax, 0.0f); \
            if (!first0) { \
                const float alpha = __builtin_amdgcn_exp2f(-delta); \
                lacc *= alpha; \
                _Pragma("unroll") for (int d = 0; d < DV / 32; ++d) _Pragma("unroll") for (int i = 0; i < 16; ++i) o[d][i] *= alpha; } \
            mrun += delta; \
            _Pragma("unroll") for (int i = 0; i < 16; ++i) { s0[i] -= delta; s1[i] -= delta; negm[i] = -mrun; } } \
        _Pragma("unroll") for (int i = 0; i < 16; ++i) { s0[i] = __builtin_amdgcn_exp2f(s0[i]); s1[i] = __builtin_amdgcn_exp2f(s1[i]); } \
        _Pragma("unroll") for (int i = 0; i < 16; i += 2) { lacc += (f32x2_t){s0[i], s0[i + 1]}; lacc += (f32x2_t){s1[i], s1[i + 1]}; } \
        _Pragma("unroll") for (int sp = 0; sp < 2; ++sp) { \
            u32x4 a, b; \
            a.x = pk2(s0[8 * sp + 0], s0[8 * sp + 1]); a.y = pk2(s0[8 * sp + 2], s0[8 * sp + 3]); a.z = pk2(s0[8 * sp + 4], s0[8 * sp + 5]); a.w = pk2(s0[8 * sp + 6], s0[8 * sp + 7]); \
            b.x = pk2(s1[8 * sp + 0], s1[8 * sp + 1]); b.y = pk2(s1[8 * sp + 2], s1[8 * sp + 3]); b.z = pk2(s1[8 * sp + 4], s1[8 * sp + 5]); b.w = pk2(s1[8 * sp + 6], s1[8 * sp + 7]); \
            pf[0][sp] = __builtin_bit_cast(bf16x8, a); pf[1][sp] = __builtin_bit_cast(bf16x8, b); } } while (0)
    constexpr bool HOISTV = (DQK <= 96);
    bf16x8 vfr[HOISTV ? DV / 32 : 1][2][2];
#define ATT_VLOAD(b_) do { if (HOISTV) { \
        _Pragma("unroll") for (int d = 0; d < DV / 32; ++d) _Pragma("unroll") for (int kb = 0; kb < 2; ++kb) _Pragma("unroll") for (int sp = 0; sp < 2; ++sp) { \
            LAS const unsigned char* vp = (b_) + vfo + (32 * kb + 16 * sp) * VP + 64 * d; \
            const s16x4 lo = vtr(vp), hi = vtr(vp + 8 * VP); \
            vfr[d][kb][sp] = __builtin_shufflevector(lo, hi, 0, 1, 2, 3, 4, 5, 6, 7); } } } while (0)
#define ATT_PV(b_) do { \
        _Pragma("unroll") for (int d = 0; d < DV / 32; ++d) _Pragma("unroll") for (int kb = 0; kb < 2; ++kb) _Pragma("unroll") for (int sp = 0; sp < 2; ++sp) { \
            if (HOISTV) { o[d] = MFMA32(vfr[d][kb][sp], pf[kb][sp], o[d]); } else { \
            LAS const unsigned char* vp = (b_) + vfo + (32 * kb + 16 * sp) * VP + 64 * d; \
            const s16x4 lo = vtr(vp), hi = vtr(vp + 8 * VP); \
            const bf16x8 vf = __builtin_shufflevector(lo, hi, 0, 1, 2, 3, 4, 5, 6, 7); \
            o[d] = MFMA32(vf, pf[kb][sp], o[d]); } } } while (0)

    const int qw0 = q0 + 32 * w;
#define ATT_ACTIVE(kt_) (MODE != 1 || ((kt_) <= qw0 + 31 + 128 && (kt_) + 63 >= qw0 - 128))
    if (KT == 128) {
    const int nt = (kend - kbeg) >> 7;
    ATT_GLOAD(a, kbeg);
    ATT_LSTORE(a, lds);
    if (nt > 1) ATT_GLOAD(a, kbeg + 128);
    __syncthreads();
    for (int T = 0; T < nt; ++T) {
        const int kt = kbeg + 128 * T;
        LAS unsigned char* buf = lds + (T & 1) * BUF; LAS unsigned char* nbuf = lds + ((T + 1) & 1) * BUF;
        ATT_QK(buf, buf + KBUF); ATT_SM(2 * T, kt); ATT_PV(buf + KBUF);
        if (T + 1 < nt) ATT_LSTORE(a, nbuf);
        if (T + 2 < nt) ATT_GLOAD(a, kt + 256);
        ATT_QK(buf + 64 * KP, buf + KBUF + 64 * VP); ATT_SM(2 * T + 1, kt + 64); ATT_PV(buf + KBUF + 64 * VP);
        __syncthreads();
    }
    } else {
    ATT_GLOAD(a, kbeg);
    ATT_LSTORE(a, lds);
    if (ntiles > 1) ATT_GLOAD(a, kbeg + 64);
    __syncthreads();
    for (int t = 0; t < ntiles; t += 2) {
        const int kt = kbeg + 64 * t;
        if (t + 2 < ntiles) ATT_GLOAD(b, kt + 128);
        if (ATT_ACTIVE(kt)) { ATT_QK(lds, lds + KBUF); ATT_SM(t, kt); ATT_PV(lds + KBUF); }
        ATT_LSTORE(a, lds + BUF);
        __syncthreads();
        if (t + 3 < ntiles) ATT_GLOAD(a, kt + 192);
        if (ATT_ACTIVE(kt + 64)) { ATT_QK(lds + BUF, lds + BUF + KBUF); ATT_SM(t + 1, kt + 64); ATT_PV(lds + BUF + KBUF); }
        if (t + 2 < ntiles) ATT_LSTORE(b, lds);
        __syncthreads();
    }
    }
#undef ATT_ACTIVE
#undef ATT_GLOAD
#undef ATT_LSTORE
#undef ATT_QK
#undef ATT_SM
#undef ATT_PV
#undef ATT_VLOAD
    float lrun = lacc.x + lacc.y;
    lrun += __shfl_xor(lrun, 32);
    const float inv = 1.0f / lrun;
    bf16_t* orow = O + (size_t)qi * ldo + 4 * h;
#pragma unroll
    for (int d = 0; d < DV / 32; ++d)
#pragma unroll
        for (int g4 = 0; g4 < 4; ++g4) {
            u32x2 wv; wv.x = pk2(o[d][4 * g4 + 0] * inv, o[d][4 * g4 + 1] * inv); wv.y = pk2(o[d][4 * g4 + 2] * inv, o[d][4 * g4 + 3] * inv);
            *(GAS u32x2*)(orow + 32 * d + 8 * g4) = wv;
        }
}

#define XB_TMO      128
#define XB_XCNT(j)  (256  + 64 * (j))
#define XB_XSUB(j)  (1280 + 64 * (j))
#define XB_XGEN(j)  (2304 + 64 * (j))
#define XB_TOP      3328
#define XB_TOPGEN   3392
#define XCD_BAR_WORDS 3456
#define XB_SPIN_CAP (1u << 18)

__device__ __forceinline__ unsigned xb_ld(unsigned* p)              { return __hip_atomic_load(p, __ATOMIC_RELAXED, __HIP_MEMORY_SCOPE_AGENT); }
__device__ __forceinline__ unsigned xb_add(unsigned* p, unsigned v) { return __hip_atomic_fetch_add(p, v, __ATOMIC_RELAXED, __HIP_MEMORY_SCOPE_AGENT); }
__device__ __forceinline__ unsigned xb_xcc_id() { return (unsigned)__builtin_amdgcn_s_getreg((3 << 11) | 20) & 0xFu; }
#define XB_SPIN(cond, bar) do { unsigned _sp = 0; while (cond) { __builtin_amdgcn_s_sleep(1); \
    if ((++_sp & 255u) == 0u) { if (xb_ld(&(bar)[XB_TMO])) break; if (_sp > XB_SPIN_CAP) { atomicAdd(&(bar)[XB_TMO], 1u); break; } } } } while (0)

struct XcdBarrier {
    unsigned* bar; unsigned x;
    volatile LAS unsigned* st;
};

__device__ __forceinline__ XcdBarrier xcd_barrier_post(unsigned* bar, volatile LAS unsigned* st) {
    XcdBarrier b; b.bar = bar; b.x = xb_xcc_id(); b.st = st;
    if (threadIdx.x == 0) (void)xb_add(&bar[XB_XCNT(b.x)], 1u);
    return b;
}
__device__ __forceinline__ void xcd_barrier_complete(unsigned* bar, unsigned x, unsigned& nloc, unsigned& nx) {
    const unsigned G = gridDim.x * gridDim.y * gridDim.z;
    unsigned sum, cnt, mine, sp = 0u;
    for (;;) {
        sum = 0u; cnt = 0u; mine = 0u;
#pragma unroll
        for (unsigned j = 0; j < 16; ++j) { const unsigned c = xb_ld(&bar[XB_XCNT(j)]); sum += c; cnt += (c > 0u) ? 1u : 0u; mine = (j == x) ? c : mine; }
        if (sum == G) break;
        __builtin_amdgcn_s_sleep(1);
        if ((++sp & 255u) == 0u) { if (xb_ld(&bar[XB_TMO])) break; if (sp > XB_SPIN_CAP) { atomicAdd(&bar[XB_TMO], 1u); break; } }
    }
    nloc = mine > 0u ? mine : 1u; nx = cnt > 0u ? cnt : 1u;
}

__device__ __forceinline__ void xcd_barrier(const XcdBarrier& b) {
    asm volatile("s_waitcnt vmcnt(0)" ::: "memory");
    __syncthreads();
    if (threadIdx.x == 0) {
        unsigned* bar = b.bar; unsigned bx = b.x; asm volatile("" : "+s"(bx));
        asm volatile("" : "+s"(bar));
        __builtin_amdgcn_s_waitcnt(0);
        unsigned nloc = b.st[0], nx = b.st[1];
        if (nloc == 0u) { xcd_barrier_complete(bar, bx, nloc, nx); b.st[0] = nloc; b.st[1] = nx; }
        const unsigned old = xb_add(&bar[XB_XSUB(bx)], 1u);
        const unsigned gen = old / nloc;
        if (old + 1u == (gen + 1u) * nloc) {
            __builtin_amdgcn_fence(__ATOMIC_RELEASE, "agent");
            asm volatile("s_waitcnt vmcnt(0)" ::: "memory");
            const unsigned og = xb_add(&bar[XB_TOP], 1u);
            const unsigned tg = og / nx;
            if (og + 1u == (tg + 1u) * nx) xb_add(&bar[XB_TOPGEN], 1u);
            else XB_SPIN(xb_ld(&bar[XB_TOPGEN]) == tg, bar);
            __builtin_amdgcn_fence(__ATOMIC_ACQUIRE, "agent");
            xb_add(&bar[XB_XGEN(bx)], 1u);
            asm volatile("s_waitcnt vmcnt(0)" ::: "memory");
        } else {
            XB_SPIN(xb_ld(&bar[XB_XGEN(bx)]) == gen, bar);
            __builtin_amdgcn_fence(__ATOMIC_ACQUIRE, "agent");
            asm volatile("s_waitcnt vmcnt(0)" ::: "memory");
        }
    }
    __syncthreads();
}

#ifndef PHMASK
#define PHMASK 0xffffffffu
#endif
#define PH(n) ((PHMASK >> (n)) & 1u)
#ifndef DUPMASK
#define DUPMASK 0u
#endif
#define DUP(n) ((DUPMASK >> (n)) & 1u)
#define GSYNC() do { xcd_barrier(xb); if (DUP(19)) xcd_barrier(xb); } while (0)
using EpiR01 = EpiResid<0, 1>; using EpiR11 = EpiResid<1, 1>; using EpiR10 = EpiResid<1, 0>;
DI int opaque_i(int v) { asm volatile("" : "+s"(v)); return v; }
#define GEMM_PHASE(EpiT, g, S, E) pg8::gemm_phase<EpiT, StaticOrder, true, true>(lds, g, S, E)


#define W1IN ((bf16_t*)(ws + WS_W1IN))
#define W1OUT ((bf16_t*)(ws + WS_W1OUT))
#define W2IN ((bf16_t*)(ws + WS_W2IN))
#define W2OUT ((bf16_t*)(ws + WS_W2OUT))
#define WIN ((bf16_t*)(ws + WS_WIN))
#define WUQ ((bf16_t*)(ws + WS_WUQ))
#define WUKV ((bf16_t*)(ws + WS_WUKV))
#define WMKV ((bf16_t*)(ws + WS_WMKV))
#define WBA ((bf16_t*)(ws + WS_WBA))
#define WBB ((bf16_t*)(ws + WS_WBB))
#define WBC ((bf16_t*)(ws + WS_WBC))
#define WOUT ((bf16_t*)(ws + WS_WOUT))
#define CS64 ((f32x2_t*)(ws + WS_CS64))
#define CS32 ((f32x2_t*)(ws + WS_CS32))
#define MEMN ((bf16_t*)(ws + WS_MEMN))
#define MEMKV ((bf16_t*)(ws + WS_MEMKV))
#define HB ((bf16_t*)(ws + WS_HB))
#define ACT ((bf16_t*)(ws + WS_ACT))
#define Z ((bf16_t*)(ws + WS_Z))
#define QB ((bf16_t*)(ws + WS_QB))
#define KVB ((bf16_t*)(ws + WS_KVB))
#define CQN ((bf16_t*)(ws + WS_CQN))
#define CKVN ((bf16_t*)(ws + WS_CKVN))
#define KRR ((bf16_t*)(ws + WS_KRR))
#define OA ((bf16_t*)(ws + WS_OA))
#define OB ((bf16_t*)(ws + WS_OB))
#define OC ((bf16_t*)(ws + WS_OC))
#define MRG ((bf16_t*)(ws + WS_MRG))
#define SS1 ((float*)(ws + WS_SS1))
#define SS2 ((float*)(ws + WS_SS2))
#define SS3 ((float*)(ws + WS_SS3))
#define XB HB
#define FRESH() unsigned char* ws = P.ws; asm volatile("" : "+s"(ws)); int tid = threadIdx.x; asm volatile("" : "+v"(tid)); const int lane = tid & 63; (void)lane; (void)tid

#define RUN_P4(tok0_) do { FRESH(); Gemm g{XB + (size_t)(tok0_) * DM, WIN, TC, ZLD, opaque_i(1024)}; StaticOrder S; S.init(TC, ZLD, G, bid); EpiWin E{Z, CS64, (tok0_), SS1 + (tok0_)}; GEMM_PHASE(EpiWin, g, S, E); } while (0)

__global__ void __launch_bounds__(512, 2) fwd_kernel(Params P) {
    extern __shared__ __attribute__((aligned(16))) unsigned char smem[];
    LAS unsigned char* lds = (LAS unsigned char*)smem;
    cg::grid_group grid = cg::this_grid();
    if (threadIdx.x < 16) ((LAS unsigned*)(lds + 131072))[threadIdx.x] = 0u;
    __syncthreads();
    if (blockIdx.x == 0) { GAS unsigned* bw = (GAS unsigned*)(P.ws + WS_BAR); for (int i = threadIdx.x; i < XCD_BAR_WORDS; i += 512) bw[i] = 0u; }
    const int wave = __builtin_amdgcn_readfirstlane(threadIdx.x >> 6);
    const int G = gridDim.x, bid = blockIdx.x;
    const int gw = bid * 8 + wave, NGW = G * 8;
    float* XR = P.out;

    for (int rep_ = 0; rep_ <= (int)DUP(0); ++rep_) if (PH(0)) {
        FRESH();
        LAS float* scr = (LAS float*)lds;
        constexpr int I0 = 8 * 88, I1 = 22 * 16, I2 = 8 * 80, I3 = 3 * 12, I4 = 2 * 16, I5 = 8 * 16, I6 = 4 * 16, I9 = 8 * 16;
        constexpr int NIT = I0 + I1 + I2 + I3 + I4 + I5 + 3 * I6 + I9 + I0 + I1;
        for (int it = bid; it < NIT; it += G) {
            int q = it;
            if (q < I0) { transpose_item(P.in[5], 1024, NFF2, W1IN, MAP_SWIGLU, 88, q, scr, tid); continue; } q -= I0;
            if (q < I1) { transpose_item(P.in[6], DFF, 1024, W1OUT, MAP_NAT, 16, q, scr, tid); continue; } q -= I1;
            if (q < I2) { transpose_item(P.in[8], 1024, 5024, WIN, MAP_WIN, 80, q, scr, tid, P.in[7]); continue; } q -= I2;
            if (q < I3) { transpose_item(P.in[10], 384, 768, WUQ, MAP_UQ, 12, q, scr, tid); continue; } q -= I3;
            if (q < I4) { transpose_item(P.in[12], 256, 1024, WUKV, MAP_NAT, 16, q, scr, tid); continue; } q -= I4;
            if (q < I5) { transpose_item(P.in[15], 1024, 1024, WMKV, MAP_NAT, 16, q, scr, tid); continue; } q -= I5;
            if (q < I6) { transpose_item(P.in[16], 512, 1024, WBA, MAP_NAT, 16, q, scr, tid); continue; } q -= I6;
            if (q < I6) { transpose_item(P.in[17], 512, 1024, WBB, MAP_NAT, 16, q, scr, tid); continue; } q -= I6;
            if (q < I6) { transpose_item(P.in[18], 512, 1024, WBC, MAP_NAT, 16, q, scr, tid); continue; } q -= I6;
            if (q < I9) { transpose_item(P.in[19], 1024, 1024, WOUT, MAP_NAT, 16, q, scr, tid); continue; } q -= I9;
            if (q < I0) { transpose_item(P.in[21], 1024, NFF2, W2IN, MAP_SWIGLU, 88, q, scr, tid, P.in[20]); continue; } q -= I0;
            transpose_item(P.in[22], DFF, 1024, W2OUT, MAP_NAT, 16, q, scr, tid);
        }
        for (int e = bid * 512 + tid; e < T_ALL; e += G * 512) { ((GAS float*)SS1)[e] = 0.f; ((GAS float*)SS2)[e] = 0.f; ((GAS float*)SS3)[e] = 0.f; }
        for (int e = bid * 512 + tid; e < 16384 * 48; e += G * 512) {
            if (e < 16384 * 32) {
                const int pos = e >> 5, i = e & 31;
                const float inv = (float)exp(-((double)(2 * i) / 64.0) * 9.210340371976184);
                float cc, ss; sincos_acc((float)pos * inv, cc, ss); ((GAS f32x2_t*)CS64)[e] = (f32x2_t){cc, ss};
            } else {
                const int e2 = e - 16384 * 32; const int pos = e2 >> 4, i = e2 & 15;
                const float inv = (float)exp(-((double)(2 * i) / 32.0) * 9.210340371976184);
                float cc, ss; sincos_acc((float)pos * inv, cc, ss); ((GAS f32x2_t*)CS32)[e2] = (f32x2_t){cc, ss};
            }
        }
        for (int m = gw; m < T_ALL; m += NGW) {
            const float* xrow = (m < 16384) ? (P.in[0] + (size_t)m * DM) : (P.in[1] + (size_t)(m - 16384) * DM);
            rms_row_bf16(xrow, P.in[4], HB + (size_t)m * DM, lane);
        }
        for (int m = gw; m < NMEMROWS; m += NGW) {
            const float* xrow = (m < 256) ? (P.in[2] + (size_t)m * DM) : (P.in[3] + (size_t)(m - 256) * DM);
            rms_row_bf16(xrow, P.in[14], MEMN + (size_t)m * DM, lane);
        }
    }
    grid.sync();
    const XcdBarrier xb = xcd_barrier_post((unsigned*)(P.ws + WS_BAR), (volatile LAS unsigned*)(lds + 131072));
    {
        FRESH();
        for (int rep_ = 0; rep_ <= (int)DUP(1); ++rep_) if (PH(1)) { Gemm g{HB, W1IN, T_ALL, NFF2, opaque_i(1024)}; StaticOrder S; S.init(T_ALL, NFF2, G, bid); EpiSwiglu E{ACT, nullptr}; GEMM_PHASE(EpiSwiglu, g, S, E); }
        for (int rep_ = 0; rep_ <= (int)DUP(2); ++rep_) if (PH(2)) { Gemm g{MEMN, WMKV, NMEMROWS, 1024, opaque_i(1024)}; StaticOrder S; S.init(NMEMROWS, 1024, G, (bid + G / 2) % G); EpiStore E{MEMKV, 1024}; GEMM_PHASE(EpiStore, g, S, E); }
    }
    GSYNC();
    for (int rep_ = 0; rep_ <= (int)DUP(3); ++rep_) if (PH(3)) { FRESH(); Gemm g{ACT, W1OUT, T_ALL, 1024, opaque_i(DFF)}; StaticOrder S; S.init(T_ALL, 1024, G, bid); EpiR01 E{P.in[0], P.in[1], 16384, XB, 0.5f, SS1}; GEMM_PHASE(EpiR01, g, S, E); }
    GSYNC();
    RUN_P4(0);
    GSYNC();
    for (int ch = 0; ch < NCHUNK; ++ch) {
        const int tok0 = ch * TC;
        {
            FRESH();
            for (int rep_ = 0; rep_ <= (int)DUP(5); ++rep_) if (PH(5)) for (int m0 = gw; m0 < TC; m0 += 4 * NGW) {
                unsigned uq[4][3], uk[4][2]; float kx1[4], kx2[4]; f32x2_t kt2[4];
#pragma unroll
                for (int r = 0; r < 4; ++r) {
                    const int m = min(m0 + r * NGW, TC - 1);
                    const GAS bf16_t* zr = (const GAS bf16_t*)Z + (size_t)m * ZLD;
#pragma unroll
                    for (int j = 0; j < 3; ++j) uq[r][j] = *(const GAS unsigned*)(zr + COL_CQ + 2 * lane + 128 * j);
#pragma unroll
                    for (int j = 0; j < 2; ++j) uk[r][j] = *(const GAS unsigned*)(zr + COL_CKV + 2 * lane + 128 * j);
                    kx1[r] = __uint_as_float((unsigned)zr[COL_KR + (lane & 15)] << 16); kx2[r] = __uint_as_float((unsigned)zr[COL_KR + 16 + (lane & 15)] << 16);
                    kt2[r] = ((const GAS f32x2_t*)CS32)[(size_t)tok_pos(tok0 + m) * 16 + (lane & 15)];
                }
                const GAS float* gq = (const GAS float*)P.in[9]; const GAS float* gk = (const GAS float*)P.in[11];
#pragma unroll
                for (int r = 0; r < 4; ++r) {
                    const int m = m0 + r * NGW;
                    if (m < TC) {
                        float v[6]; float s = 0.f;
#pragma unroll
                        for (int j = 0; j < 3; ++j) { v[2 * j] = bf_lo(uq[r][j]); v[2 * j + 1] = bf_hi(uq[r][j]); s += v[2 * j] * v[2 * j] + v[2 * j + 1] * v[2 * j + 1]; }
                        float rstd = 1.0f / sqrtf(wave_sum(s) * (1.0f / 384.0f) + RMS_EPS);
#pragma unroll
                        for (int j = 0; j < 3; ++j) { const int cidx = 2 * lane + 128 * j; *(GAS unsigned*)(CQN + (size_t)m * 384 + cidx) = pk2(v[2 * j] * rstd * gq[cidx], v[2 * j + 1] * rstd * gq[cidx + 1]); }
                        s = 0.f;
#pragma unroll
                        for (int j = 0; j < 2; ++j) { v[2 * j] = bf_lo(uk[r][j]); v[2 * j + 1] = bf_hi(uk[r][j]); s += v[2 * j] * v[2 * j] + v[2 * j + 1] * v[2 * j + 1]; }
                        rstd = 1.0f / sqrtf(wave_sum(s) * (1.0f / 256.0f) + RMS_EPS);
#pragma unroll
                        for (int j = 0; j < 2; ++j) { const int cidx = 2 * lane + 128 * j; *(GAS unsigned*)(CKVN + (size_t)m * 256 + cidx) = pk2(v[2 * j] * rstd * gk[cidx], v[2 * j + 1] * rstd * gk[cidx + 1]); }
                        if (lane < 16) {
                            ((GAS bf16_t*)KRR)[(size_t)m * 32 + lane] = (bf16_t)(pk2(kx1[r] * kt2[r].x - kx2[r] * kt2[r].y, 0.f) & 0xffffu);
                            ((GAS bf16_t*)KRR)[(size_t)m * 32 + 16 + lane] = (bf16_t)(pk2(kx2[r] * kt2[r].x + kx1[r] * kt2[r].y, 0.f) & 0xffffu);
                        }
                    }
                }
            }
            for (int rep_ = 0; rep_ <= (int)DUP(6); ++rep_) if (PH(6)) for (int u = bid; u < 512; u += G) {
                const int head = u & 7, q0 = (u >> 3) * 256;
                const int slo = (ch == 0) ? 0 : (q0 & ~4095), shi = (ch == 0) ? TC : slo + 4096;
                const int kbeg = max(slo, q0 - 128), kend = min(shi, q0 + 384);
                attn_unit<64, 64, 64, 1, 64>(lds, Z + 64 * head, ZLD, Z + COL_KA + 64 * (head >> 2), ZLD, nullptr, 0, Z + COL_VA + 64 * (head >> 2), ZLD,
                                         OA + 64 * head, 512, q0, kbeg, kend, P.in[13][head] * LOG2E);
            }
            for (int rep_ = 0; rep_ <= (int)DUP(7); ++rep_) if (PH(7)) for (int u = bid; u < 256; u += G) {
                const int head = u & 3, q0 = (u >> 2) * 256;
                const int sidx = (ch == 0) ? 0 : (1 + 4 * (ch - 1) + (q0 >> 12));
                const bf16_t* kb = MEMKV + (size_t)(256 * sidx) * 1024 + 128 * head;
                attn_unit<128, 128, 128, 0, 64>(lds, Z + COL_QC + 128 * head, ZLD, kb, 1024, nullptr, 0, kb + 512, 1024,
                                            OC + 128 * head, 512, q0, 0, 256, 0.f);
            }
        }
        GSYNC();
        {
            FRESH();
            for (int rep_ = 0; rep_ <= (int)DUP(8); ++rep_) if (PH(8)) { Gemm g{CQN, WUQ, TC, 768, opaque_i(384)}; StaticOrder S; S.init(TC, 768, G, bid); EpiUq E{QB, CS32, tok0}; GEMM_PHASE(EpiUq, g, S, E); }
            for (int rep_ = 0; rep_ <= (int)DUP(9); ++rep_) if (PH(9)) { Gemm g{CKVN, WUKV, TC, 1024, opaque_i(256)}; StaticOrder S; S.init(TC, 1024, G, (bid + 192) % G); EpiStore E{KVB, 1024}; GEMM_PHASE(EpiStore, g, S, E); }
        }
        GSYNC();
        for (int rep_ = 0; rep_ <= (int)DUP(10); ++rep_) if (PH(10)) { FRESH(); for (int u = bid; u < 512; u += G) {
            const int head = u & 7, q0 = (u >> 3) * 256;
            const int slo = (ch == 0) ? 0 : (q0 & ~4095), shi = (ch == 0) ? TC : slo + 4096;
            attn_unit<96, 64, 64, 0, 128>(lds, QB + 96 * head, 768, KVB + 128 * head, 1024, KRR, 32, KVB + 128 * head + 64, 1024,
                                     OB + 64 * head, 512, q0, slo, shi, 0.f);
        } }
        GSYNC();
        for (int rep8_ = 0; rep8_ <= (int)DUP(20); ++rep8_) if (PH(11)) {
            FRESH();
            Gemm g{OA, WBA, 3 * TC, 3 * 1024, opaque_i(512)}; Sched3 S; S.base.init(TC, 1024, G, bid); EpiGate3 E{Z, MRG};
            pg8::gemm_phase<EpiGate3, Sched3, true, true>(lds, g, S, E);
        }
        GSYNC();
        if (PH(14)) { FRESH(); bf16_t* xc = XB + (size_t)tok0 * DM; Gemm g{MRG, WOUT, TC, 1024, opaque_i(1024)}; StaticOrder S; S.init(TC, 1024, G, bid); EpiR11 E{xc, xc, 1 << 30, xc, 1.0f, SS2 + tok0}; GEMM_PHASE(EpiR11, g, S, E); }
        if (ch + 1 < NCHUNK) RUN_P4(tok0 + TC);
        GSYNC();
    }
    for (int rep_ = 0; rep_ <= (int)DUP(15); ++rep_) if (PH(15)) { FRESH(); Gemm g{XB, W2IN, T_ALL, NFF2, opaque_i(1024)}; StaticOrder S; S.init(T_ALL, NFF2, G, bid); EpiSwiglu E{ACT, SS2}; GEMM_PHASE(EpiSwiglu, g, S, E); }
    GSYNC();
    if (PH(16)) { FRESH(); Gemm g{ACT, W2OUT, T_ALL, 1024, opaque_i(DFF)}; StaticOrder S; S.init(T_ALL, 1024, G, bid); EpiR11 E{XB, XB, 1 << 30, XB, 0.5f, SS3}; GEMM_PHASE(EpiR11, g, S, E); }
    GSYNC();
    { FRESH(); for (int m = gw; m < T_ALL; m += NGW) scale_row_bf16_f32(XB + (size_t)m * DM, P.in[23], rstd_of(SS3, m), XR + (size_t)m * DM, lane); }
}

extern "C" void kernel_launch(void* const* d_in, const int* in_sizes, int n_in, void* d_out, int out_size, void* d_ws, size_t ws_size, hipStream_t stream) {
    static int grid = 0;
    if (grid == 0) {
        if (n_in != 24 || out_size != T_ALL * DM || ws_size < WS_END) { fprintf(stderr, "kernel_launch: unexpected problem (n_in %d, out %d, ws %zu, need %zu)\n", n_in, out_size, ws_size, (size_t)WS_END); grid = -1; return; }
        int dev = 0, cus = 0, per_cu = 0;
        hipGetDevice(&dev);
        hipDeviceGetAttribute(&cus, hipDeviceAttributeMultiprocessorCount, dev);
        if (hipFuncSetAttribute((const void*)fwd_kernel, hipFuncAttributeMaxDynamicSharedMemorySize, LDS_BYTES) != hipSuccess) { fprintf(stderr, "kernel_launch: hipFuncSetAttribute failed\n"); }
        if (hipOccupancyMaxActiveBlocksPerMultiprocessor(&per_cu, (const void*)fwd_kernel, 512, LDS_BYTES) != hipSuccess || per_cu < 1) { fprintf(stderr, "kernel_launch: occupancy query says %d\n", per_cu); per_cu = 1; }
        (void)hipGetLastError();
        grid = cus;
    }
    if (grid < 0) return;
    Params p{};
    for (int i = 0; i < 24; ++i) p.in[i] = (const float*)d_in[i];
    p.out = (float*)d_out; p.ws = (unsigned char*)d_ws;
    void* args[] = {&p};
    hipError_t e = hipLaunchCooperativeKernel((const void*)fwd_kernel, dim3(grid), dim3(512), args, LDS_BYTES, stream);
    if (e != hipSuccess) fprintf(stderr, "kernel_launch: cooperative launch failed: %s (grid %d)\n", hipGetErrorString(e), grid);
}
```

```cpp
#include <hip/hip_runtime.h>
#include <hip/hip_cooperative_groups.h>
#include <cstdio>
#include <cstdint>
namespace cg = cooperative_groups;

#define DI __device__ __forceinline__
#define LAS __attribute__((address_space(3)))
typedef short s16x4 __attribute__((ext_vector_type(4)));
typedef short v4i16_t __attribute__((ext_vector_type(4)));
typedef float f32x16 __attribute__((ext_vector_type(16)));
typedef float f32x2_t __attribute__((ext_vector_type(2)));
typedef __bf16 bf16x2_t __attribute__((ext_vector_type(2)));
typedef unsigned u32x2 __attribute__((ext_vector_type(2)));

namespace pg8 {
#define PG8_LAS __attribute__((address_space(3)))
typedef unsigned short bf16_t;
typedef short bf16x8 __attribute__((ext_vector_type(8)));
typedef float f32x4 __attribute__((ext_vector_type(4)));
typedef unsigned u32x4 __attribute__((ext_vector_type(4)));
constexpr int BM = 256, BK = 64, HALF = 128, HTB = HALF * BK * 2  , STAGE_BYTES = 8 * HTB, NXCD = 8, WGM = 8;

__host__ __device__ __forceinline__ int lds_byte(int r, int c) { const int st = (r >> 4) * 2 + (c >> 5), rr = r & 15, cc = c & 31, ob = rr * 64 + cc * 2; return st * 1024 + (ob ^ (((ob >> 9) & 1) << 5)); }
__host__ __device__ __forceinline__ void stage_rc(int b, int& R, int& C) { const int st = b / 1024, sb = b % 1024, swz = sb ^ (((sb >> 9) & 1) << 5); R = (st >> 1) * 16 + swz / 64; C = (st & 1) * 32 + (swz % 64) / 2; }
__host__ __device__ __forceinline__ int perm32(int rho) { const int n = rho >> 4, i = rho & 15; return 8 * (i >> 2) + 4 * n + (i & 3); }

struct Unit { int pm, pn; };
struct Gemm { const bf16_t* A; const bf16_t* Bt; int M, N, K; };

struct StaticOrder {
    int nM, nN, nwg, G, c;
    __host__ __device__ void init(int M, int N, int G_, int c_) { nM = M / BM; nN = N / BM; nwg = nM * nN; G = G_; c = c_; }
    __host__ __device__ bool next(int i, Unit& u) const {
        const long L = (long)i * G + c; if (L >= nwg) return false;
        int wgid = (int)L; { const int q = nwg / NXCD, r = nwg % NXCD, xcd = wgid % NXCD, off = wgid / NXCD; wgid = (xcd < r ? xcd * (q + 1) : r * (q + 1) + (xcd - r) * q) + off; }
        const int nig = WGM * nN, gid = wgid / nig, fm = gid * WGM, gsz = (nM - fm) < WGM ? (nM - fm) : WGM;
        u.pm = fm + ((wgid % nig) % gsz); u.pn = (wgid % nig) / gsz; return true;
    }
    __device__ __forceinline__ void a_ready(const Unit&) const {}
    __device__ __forceinline__ void done(const Unit&) const {}
};

__device__ __forceinline__ unsigned cvt_pk_bf16(float lo, float hi) { unsigned r; asm volatile("v_cvt_pk_bf16_f32 %0, %1, %2" : "=v"(r) : "v"(lo), "v"(hi)); return r; }
template <class Epi, class Sched, bool ALIGN_EPI = false, bool SP2 = false>
__device__ __forceinline__ void gemm_phase(PG8_LAS unsigned char* lds, const Gemm g, const Sched& S, const Epi& E) {
    int tid_ = threadIdx.x; asm volatile("" : "+v"(tid_));
    const int tid = tid_, wid = __builtin_amdgcn_readfirstlane(tid >> 6), lane = tid & 63, wr = wid >> 2, wc = wid & 3, fr = lane & 15, fq = lane >> 4;
    const int K = g.K, nt = K / BK;
    unsigned voffA[2], voffB[2];
#pragma unroll
    for (int i = 0; i < 2; ++i) { int R, C; stage_rc(tid * 16 + i * 8192, R, C); const int Rb = Epi::PERM ? ((R & ~31) + perm32(R & 31)) : R;
        voffA[i] = (unsigned)(R * K + C) * 2u; voffB[i] = (unsigned)(Rb * K + C) * 2u; }
    const size_t kstep = (size_t)(BK * 2);
    const size_t hstep = (size_t)HALF * K * 2;
    const size_t tstep = 2 * hstep;
    const unsigned ldsw = (unsigned)wid * 1024u;
    const int aoff = lds_byte(wr * 64 + fr, fq * 8), boff = lds_byte(wc * 32 + fr, fq * 8);
#define PG8_SA(b, h) (((b) * 2 + (h)) * HTB)
#define PG8_SB(b, h) ((4 + (b) * 2 + (h)) * HTB)
#define PG8_STAGE(bufoff, gbase, voff) do { _Pragma("unroll") for (int _i = 0; _i < 2; ++_i) \
        __builtin_amdgcn_global_load_lds((const unsigned*)((const char*)(gbase) + (voff)[_i]), (PG8_LAS unsigned*)(lds + (bufoff) + ldsw + _i * 8192), 16, 0, 0); } while (0)
#define PG8_LDA(dst, b, h) do { _Pragma("unroll") for (int m = 0; m < 4; ++m) _Pragma("unroll") for (int k = 0; k < 2; ++k) dst[m][k] = *(const PG8_LAS bf16x8*)(lds + PG8_SA(b, h) + aoff + m * 2048 + k * 1024); } while (0)
#define PG8_LDB(dst, b, h) do { _Pragma("unroll") for (int n = 0; n < 2; ++n) _Pragma("unroll") for (int k = 0; k < 2; ++k) dst[n][k] = *(const PG8_LAS bf16x8*)(lds + PG8_SB(b, h) + boff + n * 2048 + k * 1024); } while (0)
#define PG8_MMA(ai, bj, At, Bt) do { __builtin_amdgcn_s_setprio(1); _Pragma("unroll") for (int m = 0; m < 4; ++m) _Pragma("unroll") for (int n = 0; n < 2; ++n) _Pragma("unroll") for (int k = 0; k < 2; ++k) \
        acc[ai][bj][m][n] = __builtin_amdgcn_mfma_f32_16x16x32_bf16(Bt[n][k], At[m][k], acc[ai][bj][m][n], 0, 0, 0); __builtin_amdgcn_s_setprio(0); } while (0)
#define PG8_WAIT_V(n) asm volatile("s_waitcnt vmcnt(" #n ")" ::: "memory")
#define PG8_WAIT_L(n) asm volatile("s_waitcnt lgkmcnt(" #n ")" ::: "memory")
#define PG8_BAR __builtin_amdgcn_s_barrier()
#define PG8_SCHED __builtin_amdgcn_sched_barrier(0)
    Unit cur, nxt; int ui = 0;
    if (!S.next(0, cur)) return;
    f32x4 acc[2][2][4][2];
#pragma unroll
    for (int a = 0; a < 2; ++a)
#pragma unroll
        for (int b = 0; b < 2; ++b)
#pragma unroll
            for (int m = 0; m < 4; ++m)
#pragma unroll
                for (int n = 0; n < 2; ++n) acc[a][b][m][n] = (f32x4){0.f, 0.f, 0.f, 0.f};
    bf16x8 At[4][2], B0[2][2], B1[2][2];
    const char* cA = (const char*)g.A + (size_t)cur.pm * tstep; const char* cB = (const char*)g.Bt + (size_t)cur.pn * tstep;
    S.a_ready(cur);
    if constexpr (SP2) {
        PG8_STAGE(PG8_SB(0, 0), cB, voffB); PG8_STAGE(PG8_SB(0, 1), cB + hstep, voffB); PG8_STAGE(PG8_SA(0, 0), cA, voffA); PG8_STAGE(PG8_SA(0, 1), cA + hstep, voffA);
        if (wr == 1) PG8_BAR;
        PG8_WAIT_V(2); PG8_BAR;
        PG8_STAGE(PG8_SB(1, 0), cB + kstep, voffB); PG8_STAGE(PG8_SA(1, 0), cA + kstep, voffA); PG8_STAGE(PG8_SB(1, 1), cB + hstep + kstep, voffB);
        PG8_WAIT_V(6); PG8_BAR;
    } else {
        PG8_STAGE(PG8_SB(0, 0), cB, voffB); PG8_STAGE(PG8_SA(0, 0), cA, voffA); PG8_STAGE(PG8_SB(0, 1), cB + hstep, voffB); PG8_STAGE(PG8_SA(0, 1), cA + hstep, voffA);
        if (wr == 1) PG8_BAR;
        PG8_WAIT_V(4); PG8_BAR;
        PG8_STAGE(PG8_SB(1, 0), cB + kstep, voffB); PG8_STAGE(PG8_SA(1, 0), cA + kstep, voffA); PG8_STAGE(PG8_SB(1, 1), cB + hstep + kstep, voffB);
        PG8_WAIT_V(6); PG8_BAR;
    }
    for (;;) {
        const bool has_next = S.next(ui + 1, nxt);
        const char* nA = has_next ? (const char*)g.A + (size_t)nxt.pm * tstep : cA; const char* nB = has_next ? (const char*)g.Bt + (size_t)nxt.pn * tstep : cB;
        for (int t = 0; t < nt; t += 2) {
            const bool last = (t == nt - 2);
            const char* a1 = cA + (size_t)(t + 1) * kstep;
            const char* a2 = last ? nA : cA + (size_t)(t + 2) * kstep; const char* b2 = last ? nB : cB + (size_t)(t + 2) * kstep;
            const char* a3 = a2 + kstep; const char* b3 = b2 + kstep;
            if (last && has_next) S.a_ready(nxt);
            if constexpr (SP2) {
            PG8_LDB(B0, 0, 0); PG8_LDB(B1, 0, 1); PG8_SCHED; PG8_LDA(At, 0, 0); PG8_STAGE(PG8_SA(1, 1), a1 + hstep, voffA);
            PG8_WAIT_V(8); PG8_WAIT_L(0); PG8_BAR; PG8_MMA(0, 0, At, B0); PG8_MMA(0, 1, At, B1); PG8_BAR; PG8_SCHED;
            PG8_LDA(At, 0, 1); PG8_STAGE(PG8_SB(0, 0), b2, voffB); PG8_STAGE(PG8_SB(0, 1), b2 + hstep, voffB); PG8_STAGE(PG8_SA(0, 0), a2, voffA);
            PG8_WAIT_V(8); PG8_WAIT_L(0); PG8_BAR; PG8_MMA(1, 0, At, B0); PG8_MMA(1, 1, At, B1); PG8_BAR; PG8_SCHED;
            PG8_LDB(B0, 1, 0); PG8_LDB(B1, 1, 1); PG8_SCHED; PG8_LDA(At, 1, 0); PG8_STAGE(PG8_SA(0, 1), a2 + hstep, voffA);
            PG8_WAIT_V(8); PG8_WAIT_L(0); PG8_BAR; PG8_MMA(0, 0, At, B0); PG8_MMA(0, 1, At, B1); PG8_BAR; PG8_SCHED;
            PG8_LDA(At, 1, 1); PG8_STAGE(PG8_SB(1, 0), b3, voffB); PG8_STAGE(PG8_SB(1, 1), b3 + hstep, voffB); PG8_STAGE(PG8_SA(1, 0), a3, voffA);
            PG8_WAIT_V(8); PG8_WAIT_L(0); PG8_BAR; PG8_MMA(1, 0, At, B0); PG8_MMA(1, 1, At, B1); PG8_BAR; PG8_SCHED;
            } else {
            PG8_LDB(B0, 0, 0); PG8_SCHED; PG8_LDA(At, 0, 0); PG8_STAGE(PG8_SA(1, 1), a1 + hstep, voffA);
            PG8_WAIT_L(8); PG8_BAR; PG8_WAIT_L(0); PG8_MMA(0, 0, At, B0); PG8_BAR; PG8_SCHED;
            PG8_LDB(B1, 0, 1); PG8_STAGE(PG8_SB(0, 0), b2, voffB);
            PG8_BAR; PG8_WAIT_L(0); PG8_MMA(0, 1, At, B1); PG8_BAR;
            PG8_LDA(At, 0, 1); PG8_STAGE(PG8_SA(0, 0), a2, voffA);
            PG8_BAR; PG8_WAIT_L(0); PG8_MMA(1, 0, At, B0); PG8_BAR; PG8_SCHED;
            PG8_STAGE(PG8_SB(0, 1), b2 + hstep, voffB);
            PG8_WAIT_V(6); PG8_BAR; PG8_MMA(1, 1, At, B1); PG8_BAR;
            PG8_LDB(B0, 1, 0); PG8_SCHED; PG8_LDA(At, 1, 0); PG8_STAGE(PG8_SA(0, 1), a2 + hstep, voffA);
            PG8_WAIT_L(8); PG8_BAR; PG8_WAIT_L(0); PG8_MMA(0, 0, At, B0); PG8_BAR; PG8_SCHED;
            PG8_LDB(B1, 1, 1); PG8_STAGE(PG8_SB(1, 0), b3, voffB);
            PG8_BAR; PG8_WAIT_L(0); PG8_MMA(0, 1, At, B1); PG8_BAR;
            PG8_LDA(At, 1, 1); PG8_STAGE(PG8_SA(1, 0), a3, voffA);
            PG8_BAR; PG8_WAIT_L(0); PG8_MMA(1, 0, At, B0); PG8_BAR; PG8_SCHED;
            PG8_STAGE(PG8_SB(1, 1), b3 + hstep, voffB);
            PG8_WAIT_V(6); PG8_BAR; PG8_MMA(1, 1, At, B1); PG8_BAR;
            }
        }
        if constexpr (ALIGN_EPI) { if (wr == 0) PG8_BAR; }
        if constexpr (!Epi::AFTER_DRAIN) { E(acc, cur, wr, wc, fr, fq); S.done(cur); }
        if (!has_next) break;
#pragma unroll
        for (int a = 0; a < 2; ++a)
#pragma unroll
            for (int b = 0; b < 2; ++b)
#pragma unroll
                for (int m = 0; m < 4; ++m)
#pragma unroll
                    for (int n = 0; n < 2; ++n) acc[a][b][m][n] = (f32x4){0.f, 0.f, 0.f, 0.f};
        cur = nxt; cA = nA; cB = nB; ++ui;
        if constexpr (ALIGN_EPI) { if (wr == 1) PG8_BAR; }
    }
    PG8_WAIT_V(0);
    if constexpr (!ALIGN_EPI) { if (wr == 0) PG8_BAR; }
    PG8_BAR;
    if constexpr (Epi::AFTER_DRAIN) { E.fused(acc, cur, wr, wc, fr, fq, lds, wid, lane); S.done(cur); }
#undef PG8_SA
#undef PG8_SB
#undef PG8_STAGE
#undef PG8_LDA
#undef PG8_LDB
#undef PG8_MMA
#undef PG8_WAIT_V
#undef PG8_WAIT_L
#undef PG8_BAR
#undef PG8_SCHED
}
}

#define GAS __attribute__((address_space(1)))
using pg8::bf16_t; using pg8::bf16x8; using pg8::f32x4; using pg8::u32x4; using pg8::Unit; using pg8::Gemm; using pg8::StaticOrder;

constexpr int T_ALL = 49152, TC = 16384, NCHUNK = 3, DM = 1024, DFF = 2816, NFF2 = 5632, ZLD = 5120, NMEMROWS = 2304;
constexpr int COL_KA = 512, COL_VA = 640, COL_CQ = 768, COL_CKV = 1152, COL_KR = 1408, COL_QC = 1440, COL_GL = 1952;
constexpr float RMS_EPS = 1e-6f;
constexpr float LOG2E = 1.4426950408889634f;
constexpr int LDS_BYTES = 131072 + 64;
constexpr float QSCALE_A = 0.125f * LOG2E, QSCALE_B = 0.10206207261596575f * LOG2E, QSCALE_C = 0.08838834764831845f * LOG2E;

constexpr size_t MiB = 1u << 20;
constexpr size_t WS_W1IN = 0;
constexpr size_t WS_W1OUT = 11 * MiB;
constexpr size_t WS_W2IN = 17 * MiB;
constexpr size_t WS_W2OUT = 28 * MiB;
constexpr size_t WS_WIN = 34 * MiB;
constexpr size_t WS_WUQ = 44 * MiB;
constexpr size_t WS_WUKV = 45 * MiB;
constexpr size_t WS_WMKV = 46 * MiB;
constexpr size_t WS_WBA = 48 * MiB, WS_WBB = 49 * MiB, WS_WBC = 50 * MiB;
constexpr size_t WS_WOUT = 51 * MiB;
constexpr size_t WS_CS64 = 53 * MiB;
constexpr size_t WS_CS32 = 57 * MiB;
constexpr size_t WS_MEMN = 59 * MiB;
constexpr size_t WS_MEMKV = 64 * MiB;
constexpr size_t WS_HB = 69 * MiB;
constexpr size_t WS_BIG = 165 * MiB;
constexpr size_t WS_ACT = WS_BIG;
constexpr size_t WS_Z = WS_BIG;
constexpr size_t WS_QB = WS_BIG + 160 * MiB;
constexpr size_t WS_KVB = WS_BIG + 184 * MiB;
constexpr size_t WS_CQN = WS_BIG + 216 * MiB;
constexpr size_t WS_CKVN = WS_BIG + 228 * MiB;
constexpr size_t WS_KRR = WS_BIG + 236 * MiB;
constexpr size_t WS_OA = WS_BIG + 237 * MiB, WS_OB = WS_BIG + 253 * MiB, WS_OC = WS_BIG + 269 * MiB;
constexpr size_t WS_MRG = WS_BIG + 285 * MiB;
constexpr size_t WS_BAR = WS_BIG + 317 * MiB;
constexpr size_t WS_SS1 = WS_BAR + 64 * 1024, WS_SS2 = WS_BAR + 320 * 1024, WS_SS3 = WS_BAR + 576 * 1024;
constexpr size_t WS_END = WS_BIG + 318 * MiB;

struct Params { const float* in[24]; float* out; unsigned char* ws; };

DI unsigned pk2(float lo, float hi) { f32x2_t v = {lo, hi}; bf16x2_t b = __builtin_convertvector(v, bf16x2_t); return __builtin_bit_cast(unsigned, b); }
DI float bf_lo(unsigned u) { return __uint_as_float(u << 16); }
DI float bf_hi(unsigned u) { return __uint_as_float(u & 0xffff0000u); }
DI float wave_sum(float v) {
#pragma unroll
    for (int o = 1; o < 64; o <<= 1) v += __shfl_xor(v, o);
    return v;
}
DI int tok_pos(int t) { return t < 16384 ? t : ((t - 16384) & 4095); }
DI float sigmoidf_(float v) { return __builtin_amdgcn_rcpf(1.0f + __expf(-v)); }

enum { MAP_NAT = 0, MAP_SWIGLU = 1, MAP_WIN = 2, MAP_UQ = 3 };
DI int slot_col(int kind, int s) {
    if (kind == MAP_NAT) return s;
    const int pn = s >> 8, bj = (s >> 7) & 1, w = s & 127;
    if (kind == MAP_SWIGLU) return bj * DFF + 128 * pn + w;
    if (kind == MAP_WIN) {
        if (pn < 2) return 256 * pn + 64 * (w >> 5) + 32 * bj + (w & 31);
        if (pn == 2) return (w < 64) ? (COL_KA + 64 * (w >> 5) + 32 * bj + (w & 31)) : (COL_VA + 64 * bj + (w - 64));
        return s < 5024 ? s : -1;
    }
    if (pn < 2) return 96 * (s >> 6) + (s & 63);
    return 96 * (w >> 4) + 64 + 16 * bj + (w & 15);
}

DI void transpose_item(const float* __restrict__ W, int K, int N, bf16_t* __restrict__ WT, int kind, int nsb, int item, LAS float* scr, int tid, const float* __restrict__ gain = nullptr) {
    const int kb = item / nsb, sb = item - kb * nsb, k0 = kb * 128, s0 = sb * 64;
    const int ts = tid & 63, tk = tid >> 6;
    const int col = slot_col(kind, s0 + ts);
    float v[16];
#pragma unroll
    for (int i = 0; i < 16; ++i) { const int k = tk + 8 * i; v[i] = (col >= 0) ? ((const GAS float*)W)[(size_t)(k0 + k) * N + col] : 0.f; }
#pragma unroll
    for (int i = 0; i < 16; ++i) { const int k = tk + 8 * i; float x = v[i]; if (gain) x *= ((const GAS float*)gain)[k0 + k]; scr[ts * 129 + k] = x; }
    __syncthreads();
#pragma unroll
    for (int h = 0; h < 2; ++h) {
        const int ch = tid + 512 * h, slot = ch >> 4, kc = ch & 15; const LAS float* s = scr + slot * 129 + 8 * kc;
        u32x4 o; o.x = pk2(s[0], s[1]); o.y = pk2(s[2], s[3]); o.z = pk2(s[4], s[5]); o.w = pk2(s[6], s[7]);
        *(GAS u32x4*)(WT + (size_t)(s0 + slot) * K + k0 + 8 * kc) = o;
    }
    __syncthreads();
}

DI void rms_row_bf16(const float* xrow, const float* g, bf16_t* orow, int lane) {
    const GAS f32x4* xr = (const GAS f32x4*)xrow + lane; const GAS f32x4* gr = (const GAS f32x4*)g + lane;
    f32x4 v[4]; float s = 0.f;
#pragma unroll
    for (int j = 0; j < 4; ++j) { v[j] = xr[64 * j]; s += (v[j].x * v[j].x + v[j].y * v[j].y) + (v[j].z * v[j].z + v[j].w * v[j].w); }
    const float rstd = 1.0f / sqrtf(wave_sum(s) * (1.0f / 1024.0f) + RMS_EPS);
    GAS u32x2* o8 = (GAS u32x2*)orow + lane;
#pragma unroll
    for (int j = 0; j < 4; ++j) { const f32x4 gg = gr[64 * j]; u32x2 o; o.x = pk2(v[j].x * rstd * gg.x, v[j].y * rstd * gg.y); o.y = pk2(v[j].z * rstd * gg.z, v[j].w * rstd * gg.w); o8[64 * j] = o; }
}
DI void rms_row_f32(const float* xrow, const float* g, float* orow, int lane) {
    const GAS f32x4* xr = (const GAS f32x4*)xrow + lane; const GAS f32x4* gr = (const GAS f32x4*)g + lane;
    f32x4 v[4]; float s = 0.f;
#pragma unroll
    for (int j = 0; j < 4; ++j) { v[j] = xr[64 * j]; s += (v[j].x * v[j].x + v[j].y * v[j].y) + (v[j].z * v[j].z + v[j].w * v[j].w); }
    const float rstd = 1.0f / sqrtf(wave_sum(s) * (1.0f / 1024.0f) + RMS_EPS);
    GAS f32x4* o = (GAS f32x4*)orow + lane;
#pragma unroll
    for (int j = 0; j < 4; ++j) { const f32x4 gg = gr[64 * j]; o[64 * j] = (f32x4){v[j].x * rstd * gg.x, v[j].y * rstd * gg.y, v[j].z * rstd * gg.z, v[j].w * rstd * gg.w}; }
}

DI void scale_row_bf16_f32(const bf16_t* xrow, const float* g, float rstd, float* orow, int lane) {
    const GAS u32x4* xr = (const GAS u32x4*)xrow + lane; const GAS f32x4* gr = (const GAS f32x4*)g + 2 * lane;
    GAS f32x4* o = (GAS f32x4*)orow + 2 * lane;
#pragma unroll
    for (int j = 0; j < 2; ++j) {
        const u32x4 v = xr[64 * j]; const f32x4 g0 = gr[128 * j], g1 = gr[128 * j + 1];
        o[128 * j] = (f32x4){bf_lo(v.x) * rstd * g0.x, bf_hi(v.x) * rstd * g0.y, bf_lo(v.y) * rstd * g0.z, bf_hi(v.y) * rstd * g0.w};
        o[128 * j + 1] = (f32x4){bf_lo(v.z) * rstd * g1.x, bf_hi(v.z) * rstd * g1.y, bf_lo(v.w) * rstd * g1.z, bf_hi(v.w) * rstd * g1.w};
    }
}
DI void sincos_acc(float ang, float& c, float& s) {
    const double x = (double)ang;
    const double kd = rint(x * 0.63661977236758134308);
    double r = fma(-kd, 1.57079632679489655800e+00, x); r = fma(-kd, 6.12323399573676603587e-17, r);
    const double r2 = r * r;
    double sp = 1.0 / 6227020800.0; sp = fma(sp, r2, -1.0 / 39916800.0); sp = fma(sp, r2, 1.0 / 362880.0); sp = fma(sp, r2, -1.0 / 5040.0);
    sp = fma(sp, r2, 1.0 / 120.0); sp = fma(sp, r2, -1.0 / 6.0); sp = fma(sp * r2, r, r);
    double cp = 1.0 / 479001600.0; cp = fma(cp, r2, -1.0 / 3628800.0); cp = fma(cp, r2, 1.0 / 40320.0); cp = fma(cp, r2, -1.0 / 720.0);
    cp = fma(cp, r2, 1.0 / 24.0); cp = fma(cp, r2, -0.5); cp = fma(cp, r2, 1.0);
    const int q = ((int)kd) & 3;
    const double sv = (q == 0) ? sp : (q == 1) ? cp : (q == 2) ? -sp : -cp;
    const double cv = (q == 0) ? cp : (q == 1) ? -sp : (q == 2) ? -cp : sp;
    c = (float)cv; s = (float)sv;
}

DI float rstd_of(const float* ss, int row) { return 1.0f / sqrtf(((const GAS float*)ss)[row] * (1.0f / 1024.0f) + RMS_EPS); }
struct EpiSwiglu {
    static constexpr bool PERM = true, AFTER_DRAIN = false;
    bf16_t* O; const float* ss;
    DI void operator()(const f32x4 (&acc)[2][2][4][2], const Unit& u, int wr, int wc, int fr, int fq) const {
        const int row0 = u.pm * 256 + wr * 64 + fr, col0 = u.pn * 128 + wc * 32 + 8 * fq;
#pragma unroll
        for (int ai = 0; ai < 2; ++ai)
#pragma unroll
            for (int m = 0; m < 4; ++m) {
                float r[8]; const float rs = ss ? rstd_of(ss, row0 + ai * 128 + m * 16) : 1.0f;
                const float c1 = -rs * LOG2E, c2 = rs * rs;
#pragma unroll
                for (int n = 0; n < 2; ++n)
#pragma unroll
                    for (int j = 0; j < 4; j += 2) {
                        const f32x2_t g2 = {acc[ai][0][m][n][j], acc[ai][0][m][n][j + 1]}, u2 = {acc[ai][1][m][n][j], acc[ai][1][m][n][j + 1]};
                        const f32x2_t t = g2 * c1; f32x2_t e; e.x = __builtin_amdgcn_exp2f(t.x); e.y = __builtin_amdgcn_exp2f(t.y);
                        const f32x2_t d = e + 1.0f; f32x2_t q; q.x = __builtin_amdgcn_rcpf(d.x); q.y = __builtin_amdgcn_rcpf(d.y);
                        const f32x2_t o2 = (g2 * u2) * (q * c2);
                        r[4 * n + j] = o2.x; r[4 * n + j + 1] = o2.y;
                    }
                u32x4 w; w.x = pk2(r[0], r[1]); w.y = pk2(r[2], r[3]); w.z = pk2(r[4], r[5]); w.w = pk2(r[6], r[7]);
                *(GAS u32x4*)(O + (size_t)(row0 + ai * 128 + m * 16) * DFF + col0) = w;
            }
    }
};
template <int RIN, int ROUT> struct EpiResid {
    static constexpr bool PERM = true, AFTER_DRAIN = false;
    const void* r0p; const void* r1p; int split; void* O; float scale; float* ss;
    struct Raw { f32x4 f[2][2]; u32x4 h[2]; };
    DI void fetch(Raw& q, const Unit& u, size_t ro) const {
#pragma unroll
        for (int bj = 0; bj < 2; ++bj) {
            if (RIN == 0) { const GAS float* rb = (u.pm * 256 < split) ? (const GAS float*)r0p : ((const GAS float*)r1p - (size_t)split * DM); q.f[bj][0] = *(const GAS f32x4*)(rb + ro + bj * 128); q.f[bj][1] = *(const GAS f32x4*)(rb + ro + bj * 128 + 4); }
            else q.h[bj] = *(const GAS u32x4*)((const GAS bf16_t*)r0p + ro + bj * 128);
        }
    }
    DI void operator()(const f32x4 (&acc)[2][2][4][2], const Unit& u, int wr, int wc, int fr, int fq) const {
        const int row0 = u.pm * 256 + wr * 64 + fr, col0 = u.pn * 256 + wc * 32 + 8 * fq;
        constexpr int NB = (RIN == 1) ? 8 : 4;
#pragma unroll
        for (int h0 = 0; h0 < 8; h0 += NB) {
            Raw q[NB];
#pragma unroll
            for (int s = 0; s < NB; ++s) fetch(q[s], u, (size_t)(row0 + ((h0 + s) >> 2) * 128 + ((h0 + s) & 3) * 16) * DM + col0);
            __builtin_amdgcn_sched_barrier(0);
#pragma unroll
            for (int s = 0; s < NB; ++s) {
                const int ai = (h0 + s) >> 2, m = (h0 + s) & 3;
                const int row = row0 + ai * 128 + m * 16;
                const size_t ro = (size_t)row * DM + col0;
                float sq = 0.f;
#pragma unroll
                for (int bj = 0; bj < 2; ++bj) {
                    f32x4 a, bb;
                    if (RIN == 0) { a = q[s].f[bj][0]; bb = q[s].f[bj][1]; }
                    else { const u32x4 g = q[s].h[bj]; a = (f32x4){bf_lo(g.x), bf_hi(g.x), bf_lo(g.y), bf_hi(g.y)}; bb = (f32x4){bf_lo(g.z), bf_hi(g.z), bf_lo(g.w), bf_hi(g.w)}; }
                    a = a + acc[ai][bj][m][0] * scale; bb = bb + acc[ai][bj][m][1] * scale;
                    if (ROUT == 0) { *(GAS f32x4*)((float*)O + ro + bj * 128) = a; *(GAS f32x4*)((float*)O + ro + bj * 128 + 4) = bb; }
                    else {
                        u32x4 w; w.x = pk2(a[0], a[1]); w.y = pk2(a[2], a[3]); w.z = pk2(bb[0], bb[1]); w.w = pk2(bb[2], bb[3]);
                        *(GAS u32x4*)((bf16_t*)O + ro + bj * 128) = w;
                        const float q0 = bf_lo(w.x), q1 = bf_hi(w.x), q2 = bf_lo(w.y), q3 = bf_hi(w.y), q4 = bf_lo(w.z), q5 = bf_hi(w.z), q6 = bf_lo(w.w), q7 = bf_hi(w.w);
                        sq += (q0 * q0 + q1 * q1) + (q2 * q2 + q3 * q3) + (q4 * q4 + q5 * q5) + (q6 * q6 + q7 * q7);
                    }
                }
                if (ROUT == 1) { sq += __shfl_xor(sq, 16); sq += __shfl_xor(sq, 32); if (fq == 0) atomicAdd(ss + row, sq); }
            }
            __builtin_amdgcn_sched_barrier(0);
        }
    }
};
struct EpiStore {
    static constexpr bool PERM = true, AFTER_DRAIN = false;
    bf16_t* O; int ldc;
    DI void operator()(const f32x4 (&acc)[2][2][4][2], const Unit& u, int wr, int wc, int fr, int fq) const {
        const int row0 = u.pm * 256 + wr * 64 + fr, col0 = u.pn * 256 + wc * 32 + 8 * fq;
#pragma unroll
        for (int ai = 0; ai < 2; ++ai)
#pragma unroll
            for (int m = 0; m < 4; ++m)
#pragma unroll
                for (int bj = 0; bj < 2; ++bj) {
                    const f32x4 v0 = acc[ai][bj][m][0], v1 = acc[ai][bj][m][1];
                    u32x4 w; w.x = pk2(v0[0], v0[1]); w.y = pk2(v0[2], v0[3]); w.z = pk2(v1[0], v1[1]); w.w = pk2(v1[2], v1[3]);
                    *(GAS u32x4*)(O + (size_t)(row0 + ai * 128 + m * 16) * ldc + col0 + bj * 128) = w;
                }
    }
};
DI void load_cs(const f32x2_t* cs, f32x4 (&tb)[4]) {
    const GAS f32x4* p = (const GAS f32x4*)cs;
#pragma unroll
    for (int q = 0; q < 4; ++q) tb[q] = p[q];
}
DI void rope_store(const f32x4 (&a0)[2], const f32x4 (&a1)[2], const f32x4 (&tb)[4], bf16_t* d1, bf16_t* d2, float sc) {
    float o1[8], o2[8];
#pragma unroll
    for (int i = 0; i < 8; ++i) {
        const float cc = ((i & 1) ? tb[i >> 1].z : tb[i >> 1].x) * sc, sn = ((i & 1) ? tb[i >> 1].w : tb[i >> 1].y) * sc;
        const float x1 = a0[i >> 2][i & 3], x2 = a1[i >> 2][i & 3];
        o1[i] = x1 * cc - x2 * sn; o2[i] = x2 * cc + x1 * sn;
    }
    u32x4 w; w.x = pk2(o1[0], o1[1]); w.y = pk2(o1[2], o1[3]); w.z = pk2(o1[4], o1[5]); w.w = pk2(o1[6], o1[7]); *(GAS u32x4*)d1 = w;
    w.x = pk2(o2[0], o2[1]); w.y = pk2(o2[2], o2[3]); w.z = pk2(o2[4], o2[5]); w.w = pk2(o2[6], o2[7]); *(GAS u32x4*)d2 = w;
}
struct EpiWin {
    static constexpr bool PERM = true, AFTER_DRAIN = false;
    bf16_t* Z; const f32x2_t* cs64; int tok0; const float* ss;
    DI void operator()(const f32x4 (&acc)[2][2][4][2], const Unit& u, int wr, int wc, int fr, int fq) const {
        const int row0 = u.pm * 256 + wr * 64 + fr;
        float rs[8];
#pragma unroll
        for (int s = 0; s < 8; ++s) rs[s] = rstd_of(ss, row0 + (s >> 2) * 128 + (s & 3) * 16);
        const bool ropew = (u.pn < 2) || (u.pn == 2 && wc < 2);
        if (ropew) {
            const int c1 = (u.pn < 2 ? 256 * u.pn : COL_KA) + 64 * wc + 8 * fq;
            const float qsc = (u.pn < 2) ? QSCALE_A : 1.0f;
#pragma unroll
            for (int ai = 0; ai < 2; ++ai) {
                f32x4 tb[4][4];
#pragma unroll
                for (int m = 0; m < 4; ++m) load_cs(cs64 + (size_t)tok_pos(tok0 + row0 + ai * 128 + m * 16) * 32 + 8 * fq, tb[m]);
                __builtin_amdgcn_sched_barrier(0);
#pragma unroll
                for (int m = 0; m < 4; ++m) {
                    bf16_t* zr = Z + (size_t)(row0 + ai * 128 + m * 16) * ZLD + c1;
                    rope_store(acc[ai][0][m], acc[ai][1][m], tb[m], zr, zr + 32, qsc * rs[ai * 4 + m]);
                }
                __builtin_amdgcn_sched_barrier(0);
            }
        } else {
#pragma unroll
            for (int bj = 0; bj < 2; ++bj) {
                const int col = (u.pn == 2) ? (COL_VA + 64 * bj + 32 * (wc - 2) + 8 * fq) : (256 * u.pn + 128 * bj + 32 * wc + 8 * fq);
                const bool sg = col >= COL_GL; const float qs = (col >= COL_QC && col < COL_GL) ? QSCALE_C : 1.0f;
#pragma unroll
                for (int ai = 0; ai < 2; ++ai)
#pragma unroll
                    for (int m = 0; m < 4; ++m) {
                        const float rq = qs * rs[ai * 4 + m];
                        f32x4 v0 = acc[ai][bj][m][0] * rq, v1 = acc[ai][bj][m][1] * rq;
                        if (sg) {
#pragma unroll
                            for (int j = 0; j < 4; ++j) { v0[j] = sigmoidf_(v0[j]); v1[j] = sigmoidf_(v1[j]); }
                        }
                        u32x4 w; w.x = pk2(v0[0], v0[1]); w.y = pk2(v0[2], v0[3]); w.z = pk2(v1[0], v1[1]); w.w = pk2(v1[2], v1[3]);
                        *(GAS u32x4*)(Z + (size_t)(row0 + ai * 128 + m * 16) * ZLD + col) = w;
                        __builtin_amdgcn_sched_barrier(0);
                    }
            }
        }
    }
};
struct EpiUq {
    static constexpr bool PERM = true, AFTER_DRAIN = false;
    bf16_t* Q; const f32x2_t* cs32; int tok0;
    DI void operator()(const f32x4 (&acc)[2][2][4][2], const Unit& u, int wr, int wc, int fr, int fq) const {
        const int row0 = u.pm * 256 + wr * 64 + fr;
        if (u.pn == 2) {
            const int head = 2 * wc + (fq >> 1), i0 = 8 * (fq & 1);
#pragma unroll
            for (int ai = 0; ai < 2; ++ai) {
                f32x4 tb[4][4];
#pragma unroll
                for (int m = 0; m < 4; ++m) load_cs(cs32 + (size_t)tok_pos(tok0 + row0 + ai * 128 + m * 16) * 16 + i0, tb[m]);
                __builtin_amdgcn_sched_barrier(0);
#pragma unroll
                for (int m = 0; m < 4; ++m) {
                    bf16_t* qr = Q + (size_t)(row0 + ai * 128 + m * 16) * 768 + 96 * head + 64 + i0;
                    rope_store(acc[ai][0][m], acc[ai][1][m], tb[m], qr, qr + 16, QSCALE_B);
                }
                __builtin_amdgcn_sched_barrier(0);
            }
        } else {
#pragma unroll
            for (int bj = 0; bj < 2; ++bj) {
                const int s = 256 * u.pn + 128 * bj + 32 * wc + 8 * fq; const int col = 96 * (s >> 6) + (s & 63);
#pragma unroll
                for (int ai = 0; ai < 2; ++ai)
#pragma unroll
                    for (int m = 0; m < 4; ++m) {
                        const f32x4 v0 = acc[ai][bj][m][0] * QSCALE_B, v1 = acc[ai][bj][m][1] * QSCALE_B;
                        u32x4 w; w.x = pk2(v0[0], v0[1]); w.y = pk2(v0[2], v0[3]); w.z = pk2(v1[0], v1[1]); w.w = pk2(v1[2], v1[3]);
                        *(GAS u32x4*)(Q + (size_t)(row0 + ai * 128 + m * 16) * 768 + col) = w;
                    }
            }
        }
    }
};
struct Sched3 {
    StaticOrder base;
    DI bool next(int i, Unit& u) const { Unit bu; const int j = i / 3, br = i - 3 * j; if (!base.next(j, bu)) return false; u.pm = 64 * br + bu.pm; u.pn = 4 * br + bu.pn; return true; }
    DI void a_ready(const Unit&) const {}
    DI void done(const Unit&) const {}
};
struct EpiGate3 {
    static constexpr bool PERM = true, AFTER_DRAIN = false;
    const bf16_t* Z; bf16_t* Mg;
    DI void operator()(const f32x4 (&acc)[2][2][4][2], const Unit& u, int wr, int wc, int fr, int fq) const {
        const int br = u.pm >> 6, pm = u.pm & 63, pn = u.pn & 3;
        const int row0 = pm * 256 + wr * 64 + fr, col0 = pn * 256 + wc * 32 + 8 * fq;
        const GAS bf16_t* zg = (const GAS bf16_t*)Z + COL_GL + 1024 * br + col0; GAS bf16_t* mg = (GAS bf16_t*)Mg + col0;
#pragma unroll
        for (int ai = 0; ai < 2; ++ai) {
            u32x4 gv[4][2], ov[4][2];
#pragma unroll
            for (int m = 0; m < 4; ++m)
#pragma unroll
                for (int bj = 0; bj < 2; ++bj) {
                    const size_t row = row0 + ai * 128 + m * 16;
                    gv[m][bj] = *(const GAS u32x4*)(zg + row * ZLD + bj * 128);
                    if (br > 0) ov[m][bj] = *(const GAS u32x4*)(mg + row * DM + bj * 128); else ov[m][bj] = (u32x4){0u, 0u, 0u, 0u};
                }
            __builtin_amdgcn_sched_barrier(0);
#pragma unroll
            for (int m = 0; m < 4; ++m)
#pragma unroll
                for (int bj = 0; bj < 2; ++bj) {
                    const size_t row = row0 + ai * 128 + m * 16;
                    const u32x4 g = gv[m][bj], o = ov[m][bj];
                    const f32x4 v0 = acc[ai][bj][m][0], v1 = acc[ai][bj][m][1];
                    float r[8] = {bf_lo(g.x) * v0[0], bf_hi(g.x) * v0[1], bf_lo(g.y) * v0[2], bf_hi(g.y) * v0[3], bf_lo(g.z) * v1[0], bf_hi(g.z) * v1[1], bf_lo(g.w) * v1[2], bf_hi(g.w) * v1[3]};
                    r[0] += bf_lo(o.x); r[1] += bf_hi(o.x); r[2] += bf_lo(o.y); r[3] += bf_hi(o.y); r[4] += bf_lo(o.z); r[5] += bf_hi(o.z); r[6] += bf_lo(o.w); r[7] += bf_hi(o.w);
                    u32x4 w; w.x = pk2(r[0], r[1]); w.y = pk2(r[2], r[3]); w.z = pk2(r[4], r[5]); w.w = pk2(r[6], r[7]);
                    *(GAS u32x4*)(mg + row * DM + bj * 128) = w;
                }
            __builtin_amdgcn_sched_barrier(0);
        }
    }
};

DI int crow16(int i, int h) { return (i & 3) + 8 * (i >> 2) + 4 * h; }
DI s16x4 vtr(LAS const unsigned char* p) { return __builtin_bit_cast(s16x4, __builtin_amdgcn_ds_read_tr16_b64_v4i16((LAS v4i16_t*)p)); }
#define MFMA32(a, b, c) __builtin_amdgcn_mfma_f32_32x32x16_bf16((a), (b), (c), 0, 0, 0)

DI float max3f(float a, float b, float c) { float r; asm("v_max3_f32 %0, %1, %2, %3" : "=v"(r) : "v"(a), "v"(b), "v"(c)); return r; }

template <int DQK, int D1, int DV, int MODE, int KT>
DI void attn_unit(LAS unsigned char* lds, const bf16_t* __restrict__ Q, int ldq, const bf16_t* __restrict__ K1, int ldk1, const bf16_t* __restrict__ K2, int ldk2,
                  const bf16_t* __restrict__ V, int ldv, bf16_t* __restrict__ O, int ldo, int q0, int kbeg, int kend, float sink_t) {
    constexpr int D2 = DQK - D1, KP = DQK * 2 + 16, VP = DV * 2 + 64  , KBUF = KT * KP, VBUF = KT * VP, BUF = KBUF + VBUF;
    constexpr int N1 = (KT * D1 / 8) / 512, NV = (KT * DV / 8) / 512, C1 = D1 / 8, CV = DV / 8;
    constexpr float THR = 6.0f;
    int tid_ = threadIdx.x; asm volatile("" : "+v"(tid_));
    const int tid = tid_, lane = tid & 63, w = __builtin_amdgcn_readfirstlane(tid >> 6), r = lane & 31, h = lane >> 5;
    const int qi = q0 + 32 * w + r;
    bf16x8 qf[DQK / 16];
    {
        const bf16_t* qrow = Q + (size_t)qi * ldq + 8 * h;
#pragma unroll
        for (int s = 0; s < DQK / 16; ++s) qf[s] = *(const GAS bf16x8*)(qrow + 16 * s);
    }
    f32x16 o[DV / 32];
#pragma unroll
    for (int d = 0; d < DV / 32; ++d)
#pragma unroll
        for (int i = 0; i < 16; ++i) o[d][i] = 0.f;
    float mrun = (MODE == 1) ? sink_t : 0.0f;
    f32x2_t lacc = {(MODE == 1 && h == 0) ? 1.0f : 0.0f, 0.0f};
    f32x16 negm;
#pragma unroll
    for (int i = 0; i < 16; ++i) negm[i] = -mrun;

    u32x4 rk1a[N1], rk2a, rva[NV], rk1b[N1], rk2b, rvb[NV];
    const int ntiles = (kend - kbeg) >> 6;
    const int i16 = lane & 15, tq = i16 >> 2, tp = i16 & 3, tg = (lane >> 4) & 1;
    const int kfo = r * KP + 16 * h;
    const int vfo = (4 * h + tq) * VP + (16 * tg + 4 * tp) * 2;
    f32x16 s0, s1;
    bf16x8 pf[2][2];
#define ATT_GLOAD(S_, kt_) do { \
        _Pragma("unroll") for (int i = 0; i < N1; ++i) { const int ci = tid + 512 * i, key = ci / C1, part = ci % C1; rk1##S_[i] = *(const GAS u32x4*)(K1 + (size_t)((kt_) + key) * ldk1 + 8 * part); } \
        if (D2 > 0 && tid < KT * 4) { const int key = tid >> 2, part = tid & 3; rk2##S_ = *(const GAS u32x4*)(K2 + (size_t)((kt_) + key) * ldk2 + 8 * part); } \
        _Pragma("unroll") for (int i = 0; i < NV; ++i) { const int ci = tid + 512 * i, key = ci / CV, part = ci % CV; rv##S_[i] = *(const GAS u32x4*)(V + (size_t)((kt_) + key) * ldv + 8 * part); } } while (0)
#define ATT_LSTORE(S_, b_) do { \
        _Pragma("unroll") for (int i = 0; i < N1; ++i) { const int ci = tid + 512 * i, key = ci / C1, part = ci % C1; *(LAS u32x4*)((b_) + key * KP + 16 * part) = rk1##S_[i]; } \
        if (D2 > 0 && tid < KT * 4) { const int key = tid >> 2, part = tid & 3; *(LAS u32x4*)((b_) + key * KP + D1 * 2 + 16 * part) = rk2##S_; } \
        _Pragma("unroll") for (int i = 0; i < NV; ++i) { const int ci = tid + 512 * i, key = ci / CV, part = ci % CV; *(LAS u32x4*)((b_) + KBUF + key * VP + 16 * part) = rv##S_[i]; } } while (0)
#define ATT_QK(b_, vb_) do { \
        if (DQK <= 96) {     \
            bf16x8 kfa[DQK / 16], kfb[DQK / 16]; \
            _Pragma("unroll") for (int s = 0; s < DQK / 16; ++s) { kfa[s] = *(const LAS bf16x8*)((b_) + kfo + 32 * s); kfb[s] = *(const LAS bf16x8*)((b_) + kfo + 32 * KP + 32 * s); } \
            ATT_VLOAD(vb_); \
            _Pragma("unroll") for (int s = 0; s < DQK / 16; ++s) { \
                if (s == 0) { s0 = MFMA32(kfa[0], qf[0], negm); s1 = MFMA32(kfb[0], qf[0], negm); } \
                else { s0 = MFMA32(kfa[s], qf[s], s0); s1 = MFMA32(kfb[s], qf[s], s1); } } \
        } else { \
        _Pragma("unroll") for (int s = 0; s < DQK / 16; ++s) { \
            const bf16x8 a0 = *(const LAS bf16x8*)((b_) + kfo + 32 * s); \
            const bf16x8 a1 = *(const LAS bf16x8*)((b_) + kfo + 32 * KP + 32 * s); \
            if (s == 0) { s0 = MFMA32(a0, qf[0], negm); s1 = MFMA32(a1, qf[0], negm); } \
            else { s0 = MFMA32(a0, qf[s], s0); s1 = MFMA32(a1, qf[s], s1); } } } } while (0)
#define ATT_SM(ti_, kt_) do { \
        if (MODE == 1) { \
            _Pragma("unroll") for (int i = 0; i < 16; ++i) { \
                const int key = (kt_) + crow16(i, h); const int d0 = key - qi, d1 = d0 + 32; \
                if (d0 > 128 || d0 < -128) s0[i] = -1e30f; \
                if (d1 > 128 || d1 < -128) s1[i] = -1e30f; } } \
        float ta, tb;     \
        asm volatile("s_nop 15\n\ts_nop 3\n\tv_max3_f32 %0, %1, %2, %3" : "=v"(ta) : "v"(s0[0]), "v"(s0[1]), "v"(s1[0])); \
        asm volatile("v_max3_f32 %0, %1, %2, %3" : "=v"(tb) : "v"(s0[2]), "v"(s0[3]), "v"(s1[1])); \
        asm volatile("v_max3_f32 %0, %1, %2, %3" : "=v"(ta) : "v"(ta), "v"(s1[2]), "v"(s1[3])); \
        _Pragma("unroll") for (int i = 4; i < 16; i += 4) { \
            asm volatile("v_max3_f32 %0, %1, %2, %3" : "=v"(tb) : "v"(tb), "v"(s0[i]), "v"(s0[i + 1])); \
            asm volatile("v_max3_f32 %0, %1, %2, %3" : "=v"(ta) : "v"(ta), "v"(s0[i + 2]), "v"(s0[i + 3])); \
            asm volatile("v_max3_f32 %0, %1, %2, %3" : "=v"(tb) : "v"(tb), "v"(s1[i]), "v"(s1[i + 1])); \
            asm volatile("v_max3_f32 %0, %1, %2, %3" : "=v"(ta) : "v"(ta), "v"(s1[i + 2]), "v"(s1[i + 3])); } \
        float tmax = max3f(ta, tb, tb); \
        { const auto sw_ = __builtin_amdgcn_permlane32_swap(__float_as_uint(tmax), __float_as_uint(tmax), false, false);     \
          tmax = max3f(__uint_as_float(sw_[0]), __uint_as_float(sw_[1]), tmax); } \
        const bool first0 = (MODE == 0) && ((ti_) == 0); \
        if (first0 || __any(tmax > THR)) { \
            const float delta = first0 ? tmax : fmaxf(tmax, 0.0f); \
            if (!first0) { \
                const float alpha = __builtin_amdgcn_exp2f(-delta); \
                lacc *= alpha; \
                _Pragma("unroll") for (int d = 0; d < DV / 32; ++d) _Pragma("unroll") for (int i = 0; i < 16; ++i) o[d][i] *= alpha; } \
            mrun += delta; \
            _Pragma("unroll") for (int i = 0; i < 16; ++i) { s0[i] -= delta; s1[i] -= delta; negm[i] = -mrun; } } \
        _Pragma("unroll") for (int i = 0; i < 16; ++i) { s0[i] = __builtin_amdgcn_exp2f(s0[i]); s1[i] = __builtin_amdgcn_exp2f(s1[i]); } \
        _Pragma("unroll") for (int i = 0; i < 16; i += 2) { lacc += (f32x2_t){s0[i], s0[i + 1]}; lacc += (f32x2_t){s1[i], s1[i + 1]}; } \
        _Pragma("unroll") for (int sp = 0; sp < 2; ++sp) { \
            u32x4 a, b; \
            a.x = pk2(s0[8 * sp + 0], s0[8 * sp + 1]); a.y = pk2(s0[8 * sp + 2], s0[8 * sp + 3]); a.z = pk2(s0[8 * sp + 4], s0[8 * sp + 5]); a.w = pk2(s0[8 * sp + 6], s0[8 * sp + 7]); \
            b.x = pk2(s1[8 * sp + 0], s1[8 * sp + 1]); b.y = pk2(s1[8 * sp + 2], s1[8 * sp + 3]); b.z = pk2(s1[8 * sp + 4], s1[8 * sp + 5]); b.w = pk2(s1[8 * sp + 6], s1[8 * sp + 7]); \
            pf[0][sp] = __builtin_bit_cast(bf16x8, a); pf[1][sp] = __builtin_bit_cast(bf16x8, b); } } while (0)
    constexpr bool HOISTV = (DQK <= 96);
    bf16x8 vfr[HOISTV ? DV / 32 : 1][2][2];
#define ATT_VLOAD(b_) do { if (HOISTV) { \
        _Pragma("unroll") for (int d = 0; d < DV / 32; ++d) _Pragma("unroll") for (int kb = 0; kb < 2; ++kb) _Pragma("unroll") for (int sp = 0; sp < 2; ++sp) { \
            LAS const unsigned char* vp = (b_) + vfo + (32 * kb + 16 * sp) * VP + 64 * d; \
            const s16x4 lo = vtr(vp), hi = vtr(vp + 8 * VP); \
            vfr[d][kb][sp] = __builtin_shufflevector(lo, hi, 0, 1, 2, 3, 4, 5, 6, 7); } } } while (0)
#define ATT_PV(b_) do { \
        _Pragma("unroll") for (int d = 0; d < DV / 32; ++d) _Pragma("unroll") for (int kb = 0; kb < 2; ++kb) _Pragma("unroll") for (int sp = 0; sp < 2; ++sp) { \
            if (HOISTV) { o[d] = MFMA32(vfr[d][kb][sp], pf[kb][sp], o[d]); } else { \
            LAS const unsigned char* vp = (b_) + vfo + (32 * kb + 16 * sp) * VP + 64 * d; \
            const s16x4 lo = vtr(vp), hi = vtr(vp + 8 * VP); \
            const bf16x8 vf = __builtin_shufflevector(lo, hi, 0, 1, 2, 3, 4, 5, 6, 7); \
            o[d] = MFMA32(vf, pf[kb][sp], o[d]); } } } while (0)

    const int qw0 = q0 + 32 * w;
#define ATT_ACTIVE(kt_) (MODE != 1 || ((kt_) <= qw0 + 31 + 128 && (kt_) + 63 >= qw0 - 128))
    if (KT == 128) {
    const int nt = (kend - kbeg) >> 7;
    ATT_GLOAD(a, kbeg);
    ATT_LSTORE(a, lds);
    if (nt > 1) ATT_GLOAD(a, kbeg + 128);
    __syncthreads();
    for (int T = 0; T < nt; ++T) {
        const int kt = kbeg + 128 * T;
        LAS unsigned char* buf = lds + (T & 1) * BUF; LAS unsigned char* nbuf = lds + ((T + 1) & 1) * BUF;
        ATT_QK(buf, buf + KBUF); ATT_SM(2 * T, kt); ATT_PV(buf + KBUF);
        if (T + 1 < nt) ATT_LSTORE(a, nbuf);
        if (T + 2 < nt) ATT_GLOAD(a, kt + 256);
        ATT_QK(buf + 64 * KP, buf + KBUF + 64 * VP); ATT_SM(2 * T + 1, kt + 64); ATT_PV(buf + KBUF + 64 * VP);
        __syncthreads();
    }
    } else {
    ATT_GLOAD(a, kbeg);
    ATT_LSTORE(a, lds);
    if (ntiles > 1) ATT_GLOAD(a, kbeg + 64);
    __syncthreads();
    for (int t = 0; t < ntiles; ++t) {
        const int kt = kbeg + 64 * t;
        LAS unsigned char* buf = lds + (t & 1) * BUF; LAS unsigned char* nbuf = lds + ((t + 1) & 1) * BUF;
        const bool act = ATT_ACTIVE(kt);
        if (act) ATT_QK(buf, buf + KBUF);
        if (t + 1 < ntiles) ATT_LSTORE(a, nbuf);
        if (t + 2 < ntiles) ATT_GLOAD(a, kt + 128);
        if (act) { ATT_SM(t, kt); ATT_PV(buf + KBUF); }
        __syncthreads();
    }
    }
#undef ATT_ACTIVE
#undef ATT_GLOAD
#undef ATT_LSTORE
#undef ATT_QK
#undef ATT_SM
#undef ATT_PV
#undef ATT_VLOAD
    float lrun = lacc.x + lacc.y;
    lrun += __shfl_xor(lrun, 32);
    const float inv = 1.0f / lrun;
    bf16_t* orow = O + (size_t)qi * ldo + 4 * h;
#pragma unroll
    for (int d = 0; d < DV / 32; ++d)
#pragma unroll
        for (int g4 = 0; g4 < 4; ++g4) {
            u32x2 wv; wv.x = pk2(o[d][4 * g4 + 0] * inv, o[d][4 * g4 + 1] * inv); wv.y = pk2(o[d][4 * g4 + 2] * inv, o[d][4 * g4 + 3] * inv);
            *(GAS u32x2*)(orow + 32 * d + 8 * g4) = wv;
        }
}

#define XB_TMO      128
#define XB_XCNT(j)  (256  + 64 * (j))
#define XB_XSUB(j)  (1280 + 64 * (j))
#define XB_XGEN(j)  (2304 + 64 * (j))
#define XB_TOP      3328
#define XB_TOPGEN   3392
#define XCD_BAR_WORDS 3456
#define XB_SPIN_CAP (1u << 18)

__device__ __forceinline__ unsigned xb_ld(unsigned* p)              { return __hip_atomic_load(p, __ATOMIC_RELAXED, __HIP_MEMORY_SCOPE_AGENT); }
__device__ __forceinline__ unsigned xb_add(unsigned* p, unsigned v) { return __hip_atomic_fetch_add(p, v, __ATOMIC_RELAXED, __HIP_MEMORY_SCOPE_AGENT); }
__device__ __forceinline__ unsigned xb_xcc_id() { return (unsigned)__builtin_amdgcn_s_getreg((3 << 11) | 20) & 0xFu; }
#define XB_SPIN(cond, bar) do { unsigned _sp = 0; while (cond) { __builtin_amdgcn_s_sleep(1); \
    if ((++_sp & 255u) == 0u) { if (xb_ld(&(bar)[XB_TMO])) break; if (_sp > XB_SPIN_CAP) { atomicAdd(&(bar)[XB_TMO], 1u); break; } } } } while (0)

struct XcdBarrier {
    unsigned* bar; unsigned x;
    volatile LAS unsigned* st;
};

__device__ __forceinline__ XcdBarrier xcd_barrier_post(unsigned* bar, volatile LAS unsigned* st) {
    XcdBarrier b; b.bar = bar; b.x = xb_xcc_id(); b.st = st;
    if (threadIdx.x == 0) (void)xb_add(&bar[XB_XCNT(b.x)], 1u);
    return b;
}
__device__ __forceinline__ void xcd_barrier_complete(unsigned* bar, unsigned x, unsigned& nloc, unsigned& nx) {
    const unsigned G = gridDim.x * gridDim.y * gridDim.z;
    unsigned sum, cnt, mine, sp = 0u;
    for (;;) {
        sum = 0u; cnt = 0u; mine = 0u;
#pragma unroll
        for (unsigned j = 0; j < 16; ++j) { const unsigned c = xb_ld(&bar[XB_XCNT(j)]); sum += c; cnt += (c > 0u) ? 1u : 0u; mine = (j == x) ? c : mine; }
        if (sum == G) break;
        __builtin_amdgcn_s_sleep(1);
        if ((++sp & 255u) == 0u) { if (xb_ld(&bar[XB_TMO])) break; if (sp > XB_SPIN_CAP) { atomicAdd(&bar[XB_TMO], 1u); break; } }
    }
    nloc = mine > 0u ? mine : 1u; nx = cnt > 0u ? cnt : 1u;
}

__device__ __forceinline__ void xcd_barrier(const XcdBarrier& b) {
    asm volatile("s_waitcnt vmcnt(0)" ::: "memory");
    __syncthreads();
    if (threadIdx.x == 0) {
        unsigned* bar = b.bar; unsigned bx = b.x; asm volatile("" : "+s"(bx));
        asm volatile("" : "+s"(bar));
        __builtin_amdgcn_s_waitcnt(0);
        unsigned nloc = b.st[0], nx = b.st[1];
        if (nloc == 0u) { xcd_barrier_complete(bar, bx, nloc, nx); b.st[0] = nloc; b.st[1] = nx; }
        const unsigned old = xb_add(&bar[XB_XSUB(bx)], 1u);
        const unsigned gen = old / nloc;
        if (old + 1u == (gen + 1u) * nloc) {
            __builtin_amdgcn_fence(__ATOMIC_RELEASE, "agent");
            asm volatile("s_waitcnt vmcnt(0)" ::: "memory");
            const unsigned og = xb_add(&bar[XB_TOP], 1u);
            const unsigned tg = og / nx;
            if (og + 1u == (tg + 1u) * nx) xb_add(&bar[XB_TOPGEN], 1u);
            else XB_SPIN(xb_ld(&bar[XB_TOPGEN]) == tg, bar);
            __builtin_amdgcn_fence(__ATOMIC_ACQUIRE, "agent");
            xb_add(&bar[XB_XGEN(bx)], 1u);
            asm volatile("s_waitcnt vmcnt(0)" ::: "memory");
        } else {
            XB_SPIN(xb_ld(&bar[XB_XGEN(bx)]) == gen, bar);
            __builtin_amdgcn_fence(__ATOMIC_ACQUIRE, "agent");
            asm volatile("s_waitcnt vmcnt(0)" ::: "memory");
        }
    }
    __syncthreads();
}

#ifndef PHMASK
#define PHMASK 0xffffffffu
#endif
#define PH(n) ((PHMASK >> (n)) & 1u)
#ifndef DUPMASK
#define DUPMASK 0u
#endif
#define DUP(n) ((DUPMASK >> (n)) & 1u)
#define GSYNC() do { xcd_barrier(xb); if (DUP(19)) xcd_barrier(xb); } while (0)
using EpiR01 = EpiResid<0, 1>; using EpiR11 = EpiResid<1, 1>; using EpiR10 = EpiResid<1, 0>;
DI int opaque_i(int v) { asm volatile("" : "+s"(v)); return v; }
#define GEMM_PHASE(EpiT, g, S, E) pg8::gemm_phase<EpiT, StaticOrder, true, true>(lds, g, S, E)


#define W1IN ((bf16_t*)(ws + WS_W1IN))
#define W1OUT ((bf16_t*)(ws + WS_W1OUT))
#define W2IN ((bf16_t*)(ws + WS_W2IN))
#define W2OUT ((bf16_t*)(ws + WS_W2OUT))
#define WIN ((bf16_t*)(ws + WS_WIN))
#define WUQ ((bf16_t*)(ws + WS_WUQ))
#define WUKV ((bf16_t*)(ws + WS_WUKV))
#define WMKV ((bf16_t*)(ws + WS_WMKV))
#define WBA ((bf16_t*)(ws + WS_WBA))
#define WBB ((bf16_t*)(ws + WS_WBB))
#define WBC ((bf16_t*)(ws + WS_WBC))
#define WOUT ((bf16_t*)(ws + WS_WOUT))
#define CS64 ((f32x2_t*)(ws + WS_CS64))
#define CS32 ((f32x2_t*)(ws + WS_CS32))
#define MEMN ((bf16_t*)(ws + WS_MEMN))
#define MEMKV ((bf16_t*)(ws + WS_MEMKV))
#define HB ((bf16_t*)(ws + WS_HB))
#define ACT ((bf16_t*)(ws + WS_ACT))
#define Z ((bf16_t*)(ws + WS_Z))
#define QB ((bf16_t*)(ws + WS_QB))
#define KVB ((bf16_t*)(ws + WS_KVB))
#define CQN ((bf16_t*)(ws + WS_CQN))
#define CKVN ((bf16_t*)(ws + WS_CKVN))
#define KRR ((bf16_t*)(ws + WS_KRR))
#define OA ((bf16_t*)(ws + WS_OA))
#define OB ((bf16_t*)(ws + WS_OB))
#define OC ((bf16_t*)(ws + WS_OC))
#define MRG ((bf16_t*)(ws + WS_MRG))
#define SS1 ((float*)(ws + WS_SS1))
#define SS2 ((float*)(ws + WS_SS2))
#define SS3 ((float*)(ws + WS_SS3))
#define XB HB
#define FRESH() unsigned char* ws = P.ws; asm volatile("" : "+s"(ws)); int tid = threadIdx.x; asm volatile("" : "+v"(tid)); const int lane = tid & 63; (void)lane; (void)tid

#define RUN_P4(tok0_) do { FRESH(); Gemm g{XB + (size_t)(tok0_) * DM, WIN, TC, ZLD, opaque_i(1024)}; StaticOrder S; S.init(TC, ZLD, G, bid); EpiWin E{Z, CS64, (tok0_), SS1 + (tok0_)}; GEMM_PHASE(EpiWin, g, S, E); } while (0)

__global__ void __launch_bounds__(512, 2) fwd_kernel(Params P) {
    extern __shared__ __attribute__((aligned(16))) unsigned char smem[];
    LAS unsigned char* lds = (LAS unsigned char*)smem;
    cg::grid_group grid = cg::this_grid();
    if (threadIdx.x < 16) ((LAS unsigned*)(lds + 131072))[threadIdx.x] = 0u;
    __syncthreads();
    if (blockIdx.x == 0) { GAS unsigned* bw = (GAS unsigned*)(P.ws + WS_BAR); for (int i = threadIdx.x; i < XCD_BAR_WORDS; i += 512) bw[i] = 0u; }
    const int wave = __builtin_amdgcn_readfirstlane(threadIdx.x >> 6);
    const int G = gridDim.x, bid = blockIdx.x;
    const int gw = bid * 8 + wave, NGW = G * 8;
    float* XR = P.out;

    for (int rep_ = 0; rep_ <= (int)DUP(0); ++rep_) if (PH(0)) {
        FRESH();
        LAS float* scr = (LAS float*)lds;
        constexpr int I0 = 8 * 88, I1 = 22 * 16, I2 = 8 * 80, I3 = 3 * 12, I4 = 2 * 16, I5 = 8 * 16, I6 = 4 * 16, I9 = 8 * 16;
        constexpr int NIT = I0 + I1 + I2 + I3 + I4 + I5 + 3 * I6 + I9 + I0 + I1;
        for (int it = bid; it < NIT; it += G) {
            int q = it;
            if (q < I0) { transpose_item(P.in[5], 1024, NFF2, W1IN, MAP_SWIGLU, 88, q, scr, tid); continue; } q -= I0;
            if (q < I1) { transpose_item(P.in[6], DFF, 1024, W1OUT, MAP_NAT, 16, q, scr, tid); continue; } q -= I1;
            if (q < I2) { transpose_item(P.in[8], 1024, 5024, WIN, MAP_WIN, 80, q, scr, tid, P.in[7]); continue; } q -= I2;
            if (q < I3) { transpose_item(P.in[10], 384, 768, WUQ, MAP_UQ, 12, q, scr, tid); continue; } q -= I3;
            if (q < I4) { transpose_item(P.in[12], 256, 1024, WUKV, MAP_NAT, 16, q, scr, tid); continue; } q -= I4;
            if (q < I5) { transpose_item(P.in[15], 1024, 1024, WMKV, MAP_NAT, 16, q, scr, tid); continue; } q -= I5;
            if (q < I6) { transpose_item(P.in[16], 512, 1024, WBA, MAP_NAT, 16, q, scr, tid); continue; } q -= I6;
            if (q < I6) { transpose_item(P.in[17], 512, 1024, WBB, MAP_NAT, 16, q, scr, tid); continue; } q -= I6;
            if (q < I6) { transpose_item(P.in[18], 512, 1024, WBC, MAP_NAT, 16, q, scr, tid); continue; } q -= I6;
            if (q < I9) { transpose_item(P.in[19], 1024, 1024, WOUT, MAP_NAT, 16, q, scr, tid); continue; } q -= I9;
            if (q < I0) { transpose_item(P.in[21], 1024, NFF2, W2IN, MAP_SWIGLU, 88, q, scr, tid, P.in[20]); continue; } q -= I0;
            transpose_item(P.in[22], DFF, 1024, W2OUT, MAP_NAT, 16, q, scr, tid);
        }
        for (int e = bid * 512 + tid; e < T_ALL; e += G * 512) { ((GAS float*)SS1)[e] = 0.f; ((GAS float*)SS2)[e] = 0.f; ((GAS float*)SS3)[e] = 0.f; }
        for (int e = bid * 512 + tid; e < 16384 * 48; e += G * 512) {
            if (e < 16384 * 32) {
                const int pos = e >> 5, i = e & 31;
                const float inv = (float)exp(-((double)(2 * i) / 64.0) * 9.210340371976184);
                float cc, ss; sincos_acc((float)pos * inv, cc, ss); ((GAS f32x2_t*)CS64)[e] = (f32x2_t){cc, ss};
            } else {
                const int e2 = e - 16384 * 32; const int pos = e2 >> 4, i = e2 & 15;
                const float inv = (float)exp(-((double)(2 * i) / 32.0) * 9.210340371976184);
                float cc, ss; sincos_acc((float)pos * inv, cc, ss); ((GAS f32x2_t*)CS32)[e2] = (f32x2_t){cc, ss};
            }
        }
        for (int m = gw; m < T_ALL; m += NGW) {
            const float* xrow = (m < 16384) ? (P.in[0] + (size_t)m * DM) : (P.in[1] + (size_t)(m - 16384) * DM);
            rms_row_bf16(xrow, P.in[4], HB + (size_t)m * DM, lane);
        }
        for (int m = gw; m < NMEMROWS; m += NGW) {
            const float* xrow = (m < 256) ? (P.in[2] + (size_t)m * DM) : (P.in[3] + (size_t)(m - 256) * DM);
            rms_row_bf16(xrow, P.in[14], MEMN + (size_t)m * DM, lane);
        }
    }
    grid.sync();
    const XcdBarrier xb = xcd_barrier_post((unsigned*)(P.ws + WS_BAR), (volatile LAS unsigned*)(lds + 131072));
    {
        FRESH();
        for (int rep_ = 0; rep_ <= (int)DUP(1); ++rep_) if (PH(1)) { Gemm g{HB, W1IN, T_ALL, NFF2, opaque_i(1024)}; StaticOrder S; S.init(T_ALL, NFF2, G, bid); EpiSwiglu E{ACT, nullptr}; GEMM_PHASE(EpiSwiglu, g, S, E); }
        for (int rep_ = 0; rep_ <= (int)DUP(2); ++rep_) if (PH(2)) { Gemm g{MEMN, WMKV, NMEMROWS, 1024, opaque_i(1024)}; StaticOrder S; S.init(NMEMROWS, 1024, G, (bid + G / 2) % G); EpiStore E{MEMKV, 1024}; GEMM_PHASE(EpiStore, g, S, E); }
    }
    GSYNC();
    for (int rep_ = 0; rep_ <= (int)DUP(3); ++rep_) if (PH(3)) { FRESH(); Gemm g{ACT, W1OUT, T_ALL, 1024, opaque_i(DFF)}; StaticOrder S; S.init(T_ALL, 1024, G, bid); EpiR01 E{P.in[0], P.in[1], 16384, XB, 0.5f, SS1}; GEMM_PHASE(EpiR01, g, S, E); }
    GSYNC();
    RUN_P4(0);
    GSYNC();
    for (int ch = 0; ch < NCHUNK; ++ch) {
        const int tok0 = ch * TC;
        {
            FRESH();
            for (int rep_ = 0; rep_ <= (int)DUP(5); ++rep_) if (PH(5)) for (int m0 = gw; m0 < TC; m0 += 4 * NGW) {
                unsigned uq[4][3], uk[4][2]; float kx1[4], kx2[4]; f32x2_t kt2[4];
#pragma unroll
                for (int r = 0; r < 4; ++r) {
                    const int m = min(m0 + r * NGW, TC - 1);
                    const GAS bf16_t* zr = (const GAS bf16_t*)Z + (size_t)m * ZLD;
#pragma unroll
                    for (int j = 0; j < 3; ++j) uq[r][j] = *(const GAS unsigned*)(zr + COL_CQ + 2 * lane + 128 * j);
#pragma unroll
                    for (int j = 0; j < 2; ++j) uk[r][j] = *(const GAS unsigned*)(zr + COL_CKV + 2 * lane + 128 * j);
                    kx1[r] = __uint_as_float((unsigned)zr[COL_KR + (lane & 15)] << 16); kx2[r] = __uint_as_float((unsigned)zr[COL_KR + 16 + (lane & 15)] << 16);
                    kt2[r] = ((const GAS f32x2_t*)CS32)[(size_t)tok_pos(tok0 + m) * 16 + (lane & 15)];
                }
                const GAS float* gq = (const GAS float*)P.in[9]; const GAS float* gk = (const GAS float*)P.in[11];
#pragma unroll
                for (int r = 0; r < 4; ++r) {
                    const int m = m0 + r * NGW;
                    if (m < TC) {
                        float v[6]; float s = 0.f;
#pragma unroll
                        for (int j = 0; j < 3; ++j) { v[2 * j] = bf_lo(uq[r][j]); v[2 * j + 1] = bf_hi(uq[r][j]); s += v[2 * j] * v[2 * j] + v[2 * j + 1] * v[2 * j + 1]; }
                        float rstd = 1.0f / sqrtf(wave_sum(s) * (1.0f / 384.0f) + RMS_EPS);
#pragma unroll
                        for (int j = 0; j < 3; ++j) { const int cidx = 2 * lane + 128 * j; *(GAS unsigned*)(CQN + (size_t)m * 384 + cidx) = pk2(v[2 * j] * rstd * gq[cidx], v[2 * j + 1] * rstd * gq[cidx + 1]); }
                        s = 0.f;
#pragma unroll
                        for (int j = 0; j < 2; ++j) { v[2 * j] = bf_lo(uk[r][j]); v[2 * j + 1] = bf_hi(uk[r][j]); s += v[2 * j] * v[2 * j] + v[2 * j + 1] * v[2 * j + 1]; }
                        rstd = 1.0f / sqrtf(wave_sum(s) * (1.0f / 256.0f) + RMS_EPS);
#pragma unroll
                        for (int j = 0; j < 2; ++j) { const int cidx = 2 * lane + 128 * j; *(GAS unsigned*)(CKVN + (size_t)m * 256 + cidx) = pk2(v[2 * j] * rstd * gk[cidx], v[2 * j + 1] * rstd * gk[cidx + 1]); }
                        if (lane < 16) {
                            ((GAS bf16_t*)KRR)[(size_t)m * 32 + lane] = (bf16_t)(pk2(kx1[r] * kt2[r].x - kx2[r] * kt2[r].y, 0.f) & 0xffffu);
                            ((GAS bf16_t*)KRR)[(size_t)m * 32 + 16 + lane] = (bf16_t)(pk2(kx2[r] * kt2[r].x + kx1[r] * kt2[r].y, 0.f) & 0xffffu);
                        }
                    }
                }
            }
            for (int rep_ = 0; rep_ <= (int)DUP(6); ++rep_) if (PH(6)) for (int u = bid; u < 512; u += G) {
                const int head = u & 7, q0 = (u >> 3) * 256;
                const int slo = (ch == 0) ? 0 : (q0 & ~4095), shi = (ch == 0) ? TC : slo + 4096;
                const int kbeg = max(slo, q0 - 128), kend = min(shi, q0 + 384);
                attn_unit<64, 64, 64, 1, 64>(lds, Z + 64 * head, ZLD, Z + COL_KA + 64 * (head >> 2), ZLD, nullptr, 0, Z + COL_VA + 64 * (head >> 2), ZLD,
                                         OA + 64 * head, 512, q0, kbeg, kend, P.in[13][head] * LOG2E);
            }
            for (int rep_ = 0; rep_ <= (int)DUP(7); ++rep_) if (PH(7)) for (int u = bid; u < 256; u += G) {
                const int head = u & 3, q0 = (u >> 2) * 256;
                const int sidx = (ch == 0) ? 0 : (1 + 4 * (ch - 1) + (q0 >> 12));
                const bf16_t* kb = MEMKV + (size_t)(256 * sidx) * 1024 + 128 * head;
                attn_unit<128, 128, 128, 0, 64>(lds, Z + COL_QC + 128 * head, ZLD, kb, 1024, nullptr, 0, kb + 512, 1024,
                                            OC + 128 * head, 512, q0, 0, 256, 0.f);
            }
        }
        GSYNC();
        {
            FRESH();
            for (int rep_ = 0; rep_ <= (int)DUP(8); ++rep_) if (PH(8)) { Gemm g{CQN, WUQ, TC, 768, opaque_i(384)}; StaticOrder S; S.init(TC, 768, G, bid); EpiUq E{QB, CS32, tok0}; GEMM_PHASE(EpiUq, g, S, E); }
            for (int rep_ = 0; rep_ <= (int)DUP(9); ++rep_) if (PH(9)) { Gemm g{CKVN, WUKV, TC, 1024, opaque_i(256)}; StaticOrder S; S.init(TC, 1024, G, (bid + 192) % G); EpiStore E{KVB, 1024}; GEMM_PHASE(EpiStore, g, S, E); }
        }
        GSYNC();
        for (int rep_ = 0; rep_ <= (int)DUP(10); ++rep_) if (PH(10)) { FRESH(); for (int u = bid; u < 512; u += G) {
            const int head = u & 7, q0 = (u >> 3) * 256;
            const int slo = (ch == 0) ? 0 : (q0 & ~4095), shi = (ch == 0) ? TC : slo + 4096;
            attn_unit<96, 64, 64, 0, 128>(lds, QB + 96 * head, 768, KVB + 128 * head, 1024, KRR, 32, KVB + 128 * head + 64, 1024,
                                     OB + 64 * head, 512, q0, slo, shi, 0.f);
        } }
        GSYNC();
        for (int rep8_ = 0; rep8_ <= (int)DUP(20); ++rep8_) if (PH(11)) {
            FRESH();
            Gemm g{OA, WBA, 3 * TC, 3 * 1024, opaque_i(512)}; Sched3 S; S.base.init(TC, 1024, G, bid); EpiGate3 E{Z, MRG};
            pg8::gemm_phase<EpiGate3, Sched3, true, true>(lds, g, S, E);
        }
        GSYNC();
        if (PH(14)) { FRESH(); bf16_t* xc = XB + (size_t)tok0 * DM; Gemm g{MRG, WOUT, TC, 1024, opaque_i(1024)}; StaticOrder S; S.init(TC, 1024, G, bid); EpiR11 E{xc, xc, 1 << 30, xc, 1.0f, SS2 + tok0}; GEMM_PHASE(EpiR11, g, S, E); }
        if (ch + 1 < NCHUNK) RUN_P4(tok0 + TC);
        GSYNC();
    }
    for (int rep_ = 0; rep_ <= (int)DUP(15); ++rep_) if (PH(15)) { FRESH(); Gemm g{XB, W2IN, T_ALL, NFF2, opaque_i(1024)}; StaticOrder S; S.init(T_ALL, NFF2, G, bid); EpiSwiglu E{ACT, SS2}; GEMM_PHASE(EpiSwiglu, g, S, E); }
    GSYNC();
    if (PH(16)) { FRESH(); Gemm g{ACT, W2OUT, T_ALL, 1024, opaque_i(DFF)}; StaticOrder S; S.init(T_ALL, 1024, G, bid); EpiR11 E{XB, XB, 1 << 30, XB, 0.5f, SS3}; GEMM_PHASE(EpiR11, g, S, E); }
    GSYNC();
    { FRESH(); for (int m = gw; m < T_ALL; m += NGW) scale_row_bf16_f32(XB + (size_t)m * DM, P.in[23], rstd_of(SS3, m), XR + (size_t)m * DM, lane); }
}

extern "C" void kernel_launch(void* const* d_in, const int* in_sizes, int n_in, void* d_out, int out_size, void* d_ws, size_t ws_size, hipStream_t stream) {
    static int grid = 0;
    if (grid == 0) {
        if (n_in != 24 || out_size != T_ALL * DM || ws_size < WS_END) { fprintf(stderr, "kernel_launch: unexpected problem (n_in %d, out %d, ws %zu, need %zu)\n", n_in, out_size, ws_size, (size_t)WS_END); grid = -1; return; }
        int dev = 0, cus = 0, per_cu = 0;
        hipGetDevice(&dev);
        hipDeviceGetAttribute(&cus, hipDeviceAttributeMultiprocessorCount, dev);
        if (hipFuncSetAttribute((const void*)fwd_kernel, hipFuncAttributeMaxDynamicSharedMemorySize, LDS_BYTES) != hipSuccess) { fprintf(stderr, "kernel_launch: hipFuncSetAttribute failed\n"); }
        if (hipOccupancyMaxActiveBlocksPerMultiprocessor(&per_cu, (const void*)fwd_kernel, 512, LDS_BYTES) != hipSuccess || per_cu < 1) { fprintf(stderr, "kernel_launch: occupancy query says %d\n", per_cu); per_cu = 1; }
        (void)hipGetLastError();
        grid = cus;
    }
    if (grid < 0) return;
    Params p{};
    for (int i = 0; i < 24; ++i) p.in[i] = (const float*)d_in[i];
    p.out = (float*)d_out; p.ws = (unsigned char*)d_ws;
    void* args[] = {&p};
    hipError_t e = hipLaunchCooperativeKernel((const void*)fwd_kernel, dim3(grid), dim3(512), args, LDS_BYTES, stream);
    if (e != hipSuccess) fprintf(stderr, "kernel_launch: cooperative launch failed: %s (grid %d)\n", hipGetErrorString(e), grid);
}
```
